# Optimizing an MI355X kernel written in HIP

```python
import numpy as np
import jax
import jax.numpy as jnp
from jax import lax

D_MODEL = 4096
BATCH = 8
SEQ = 2048
DEPTH = 1

HEAD_DIM = 128
MIX_WIDTH = D_MODEL
POOL_WINDOWS = (2, 4, 8, 16)
POOL_WIDTH = MIX_WIDTH // 4
POOL_GROUP = POOL_WIDTH // len(POOL_WINDOWS)
NSA_WIDTH = MIX_WIDTH - POOL_WIDTH
NSA_HEADS = NSA_WIDTH // HEAD_DIM
NSA_GROUP = 6
NSA_KV_HEADS = NSA_HEADS // NSA_GROUP
N_BRANCH = 3
KV_WIDTH = N_BRANCH * 2 * NSA_KV_HEADS * HEAD_DIM
GATE_WIDTH = NSA_HEADS * N_BRANCH
IN_WIDTH = POOL_WIDTH + NSA_WIDTH + KV_WIDTH + GATE_WIDTH
CMP_BLOCK = 32
CMP_STRIDE = 16
CMP_HIDDEN = 256
SEL_BLOCK = 64
SEL_TOPN = 16
WINDOW = 512
Q_BLOCK = 16
FORCE_BONUS = 1000.0
NEG_SCORE = -1e9
ROPE_THETA = 10000.0
PEER_HEADS = 8
PEER_KEY_DIM = 256
PEER_NKEYS = 128
PEER_EXPERTS = PEER_NKEYS * PEER_NKEYS
PEER_TOPK = 16
PEER_CHUNK = 64
NORM_EPS = 1e-6
N_MOD = 6

kernel_name = 'hybrid_pool_nsa_peer_block'


def rmsnorm(x, g):
    xf = x.astype(jnp.float32)
    y = xf * lax.rsqrt(jnp.mean(xf * xf, axis=-1, keepdims=True) + NORM_EPS)
    return (y * g.astype(jnp.float32)).astype(x.dtype)


def rope(x, pos):
    half = HEAD_DIM // 2
    inv = ROPE_THETA ** (-jnp.arange(half, dtype=jnp.float32) / half)
    ang = pos[:, None] * inv[None, :]
    cos = jnp.cos(ang)[:, None, :]
    sin = jnp.sin(ang)[:, None, :]
    xf = x.astype(jnp.float32)
    x1, x2 = xf[..., :half], xf[..., half:]
    return jnp.concatenate([x1 * cos - x2 * sin, x2 * cos + x1 * sin], axis=-1).astype(x.dtype)


def masked_softmax(s, mask):
    s = jnp.where(mask, s.astype(jnp.float32), -jnp.inf)
    m = jnp.max(s, axis=-1, keepdims=True)
    m = jnp.where(jnp.isfinite(m), m, 0.0)
    p = jnp.exp(s - m)
    den = jnp.sum(p, axis=-1, keepdims=True)
    return p / jnp.where(den > 0, den, 1.0)


def pool_mixer(p, w_pool, pool_scale):
    B_, T_, _ = p.shape
    pg = p.reshape(B_, T_, len(POOL_WINDOWS), POOL_GROUP).astype(jnp.float32)
    cs = jnp.cumsum(pg, axis=1)
    count = jnp.arange(1, T_ + 1, dtype=jnp.float32)[None, :, None]
    groups = []
    for gi, w in enumerate(POOL_WINDOWS):
        c_g = cs[:, :, gi]
        lag = jnp.pad(c_g, ((0, 0), (w, 0), (0, 0)))[:, :T_]
        groups.append((c_g - lag) / jnp.minimum(count, float(w)) - pg[:, :, gi])
    d = jnp.stack(groups, axis=2).astype(p.dtype)
    y = jnp.einsum('btgc,gcd->btgd', d, w_pool)
    return y.reshape(B_, T_, POOL_WIDTH) * pool_scale


def compress_blocks(k_raw, blk, pe, w1, w2):
    kb = k_raw[:, blk] + pe[None, None, :, None, :]
    hid = jax.nn.gelu(jnp.einsum('bnlgd,ldh->bngh', kb, w1), approximate=False)
    return jnp.einsum('bngh,hd->bngd', hid, w2)


def cmp_to_sel_matrix(n_cmp, n_sel):
    cst = np.arange(n_cmp)[:, None] * CMP_STRIDE
    sst = np.arange(n_sel)[None, :] * SEL_BLOCK
    ov = np.clip(np.minimum(cst + CMP_BLOCK, sst + SEL_BLOCK) - np.maximum(cst, sst), 0, None)
    return jnp.asarray(ov / CMP_BLOCK, dtype=jnp.float32)


def nsa_mixer(q_in, kv_in, g_in, q_norm_g, k_norm_g, cmp_pe, cmp_w1, cmp_w2):
    B_, T_, _ = q_in.shape
    G, R, Dh = NSA_KV_HEADS, NSA_GROUP, HEAD_DIM
    pos = jnp.arange(T_, dtype=jnp.float32)
    qn = rmsnorm(q_in.reshape(B_, T_, NSA_HEADS, Dh), q_norm_g)
    qr = rope(qn, pos).reshape(B_, T_, G, R, Dh)
    qn = qn.reshape(B_, T_, G, R, Dh)
    kv = kv_in.reshape(B_, T_, N_BRANCH, 2, G, Dh)
    n_cmp = (T_ - CMP_BLOCK) // CMP_STRIDE + 1
    blk = np.arange(n_cmp)[:, None] * CMP_STRIDE + np.arange(CMP_BLOCK)[None, :]
    k_cmp = rmsnorm(compress_blocks(kv[:, :, 0, 0], blk, cmp_pe[0], cmp_w1[0], cmp_w2[0]), k_norm_g[0])
    v_cmp = compress_blocks(kv[:, :, 0, 1], blk, cmp_pe[1], cmp_w1[1], cmp_w2[1])
    cmp_end = jnp.arange(n_cmp) * CMP_STRIDE + (CMP_BLOCK - 1)
    n_sel = T_ // SEL_BLOCK
    top_n = min(SEL_TOPN, n_sel)
    sel_map = cmp_to_sel_matrix(n_cmp, n_sel)
    sel_ids = jnp.arange(n_sel)
    sel_start = sel_ids * SEL_BLOCK
    k_sel = rope(rmsnorm(kv[:, :, 1, 0], k_norm_g[1]), pos)
    k_sel = k_sel.reshape(B_, n_sel, SEL_BLOCK, G, Dh).transpose(0, 3, 1, 2, 4)
    v_sel = kv[:, :, 1, 1].reshape(B_, n_sel, SEL_BLOCK, G, Dh).transpose(0, 3, 1, 2, 4)
    pad = ((0, 0), (WINDOW, 0), (0, 0), (0, 0))
    k_win = jnp.pad(rope(rmsnorm(kv[:, :, 2, 0], k_norm_g[2]), pos), pad)
    v_win = jnp.pad(kv[:, :, 2, 1], pad)
    gates = jax.nn.sigmoid(g_in.astype(jnp.float32)).reshape(B_, T_, G, R, N_BRANCH)
    b_ix = jnp.arange(B_)[:, None, None, None]
    g_ix = jnp.arange(G)[None, None, :, None]
    scale = Dh ** -0.5

    def block_step(qb):
        t0 = qb * Q_BLOCK
        t = t0 + jnp.arange(Q_BLOCK)
        qn_b = lax.dynamic_slice_in_dim(qn, t0, Q_BLOCK, axis=1)
        qr_b = lax.dynamic_slice_in_dim(qr, t0, Q_BLOCK, axis=1)
        g_b = lax.dynamic_slice_in_dim(gates, t0, Q_BLOCK, axis=1)
        s_c = jnp.einsum('bqgrd,bngd->bqgrn', qn_b, k_cmp) * scale
        m_c = (cmp_end[None, :] <= t[:, None])[None, :, None, None, :]
        p_c = masked_softmax(s_c, m_c)
        o_c = jnp.einsum('bqgrn,bngd->bqgrd', p_c, v_cmp)
        imp = jnp.einsum('bqgrn,nj->bqgj', p_c, sel_map)
        cur = t // SEL_BLOCK
        forced = (sel_ids[None, :] == 0) | (sel_ids[None, :] == cur[:, None]) | (sel_ids[None, :] == cur[:, None] - 1)
        valid = sel_start[None, :] <= t[:, None]
        score = jnp.where(valid[None, :, None, :], imp + jnp.where(forced, FORCE_BONUS, 0.0)[None, :, None, :], NEG_SCORE)
        _, idx = lax.top_k(score, top_n)
        k_g = k_sel[b_ix, g_ix, idx]
        v_g = v_sel[b_ix, g_ix, idx]
        s_s = jnp.einsum('bqgrd,bqgkld->bqgrkl', qr_b, k_g) * scale
        tok = idx[..., None] * SEL_BLOCK + jnp.arange(SEL_BLOCK)
        m_s = (tok <= t[None, :, None, None, None]).reshape(B_, Q_BLOCK, G, 1, top_n * SEL_BLOCK)
        p_s = masked_softmax(s_s.reshape(B_, Q_BLOCK, G, R, top_n * SEL_BLOCK), m_s)
        o_s = jnp.einsum('bqgrn,bqgnd->bqgrd', p_s, v_g.reshape(B_, Q_BLOCK, G, top_n * SEL_BLOCK, Dh))
        k_wb = lax.dynamic_slice_in_dim(k_win, t0, WINDOW + Q_BLOCK, axis=1)
        v_wb = lax.dynamic_slice_in_dim(v_win, t0, WINDOW + Q_BLOCK, axis=1)
        s_w = jnp.einsum('bqgrd,bsgd->bqgrs', qr_b, k_wb) * scale
        spos = t0 - WINDOW + jnp.arange(WINDOW + Q_BLOCK)
        dist = t[:, None] - spos[None, :]
        m_w = ((dist >= 0) & (dist < WINDOW) & (spos[None, :] >= 0))[None, :, None, None, :]
        p_w = masked_softmax(s_w, m_w)
        o_w = jnp.einsum('bqgrs,bsgd->bqgrd', p_w, v_wb)
        o = g_b[..., 0:1] * o_c + g_b[..., 1:2] * o_s + g_b[..., 2:3] * o_w
        return o.reshape(B_, Q_BLOCK, NSA_WIDTH).astype(q_in.dtype)

    out = lax.map(block_step, jnp.arange(T_ // Q_BLOCK))
    return out.transpose(1, 0, 2, 3).reshape(B_, T_, NSA_WIDTH)


def peer_ffn(h, w_pq, peer_keys, peer_u, peer_v):
    B_, T_, D_ = h.shape
    q = jnp.dot(h, w_pq).reshape(B_, T_, PEER_HEADS, 2, PEER_KEY_DIM // 2).astype(jnp.float32)
    s = jnp.einsum('bthcd,hckd->bthck', q, peer_keys.astype(jnp.float32))
    v, i = lax.top_k(s, PEER_TOPK)
    cand_s = (v[..., 0, :, None] + v[..., 1, None, :]).reshape(B_, T_, PEER_HEADS, PEER_TOPK * PEER_TOPK)
    cand_i = (i[..., 0, :, None] * PEER_NKEYS + i[..., 1, None, :]).reshape(B_, T_, PEER_HEADS, PEER_TOPK * PEER_TOPK)
    top_s, sel = lax.top_k(cand_s, PEER_TOPK)
    e_idx = jnp.take_along_axis(cand_i, sel, axis=-1)
    g = jax.nn.softmax(top_s, axis=-1)
    n_chunks = (B_ * T_) // PEER_CHUNK
    xt = h.reshape(n_chunks, PEER_CHUNK, D_)
    et = e_idx.reshape(n_chunks, PEER_CHUNK, PEER_HEADS * PEER_TOPK)
    gt = g.reshape(n_chunks, PEER_CHUNK, PEER_HEADS * PEER_TOPK)

    def chunk(args):
        xc, ec, gc = args
        u = peer_u[ec]
        a = jax.nn.gelu(jnp.einsum('nd,nkd->nk', xc, u).astype(jnp.float32), approximate=False)
        return jnp.einsum('nk,nkd->nd', (gc * a).astype(xc.dtype), peer_v[ec])

    y = lax.map(chunk, (xt, et, gt))
    return y.reshape(B_, T_, D_)


def hybrid_layer(x, c, w_ada, b_ada, norm1_g, norm2_g, w_in, w_out, w_pool, pool_scale,
                 q_norm_g, k_norm_g, cmp_pe, cmp_w1, cmp_w2, w_pq, peer_keys, peer_u, peer_v):
    mod = jnp.dot(jax.nn.silu(c), w_ada) + b_ada
    shift1, scale1, gate1, shift2, scale2, gate2 = [m[:, None, :] for m in jnp.split(mod, N_MOD, axis=-1)]
    h = rmsnorm(x, norm1_g) * (1.0 + scale1) + shift1
    proj = jnp.dot(h, w_in)
    p_in, q_in, kv_in, g_in = jnp.split(
        proj, [POOL_WIDTH, POOL_WIDTH + NSA_WIDTH, POOL_WIDTH + NSA_WIDTH + KV_WIDTH], axis=-1)
    y_pool = pool_mixer(p_in, w_pool, pool_scale)
    y_nsa = nsa_mixer(q_in, kv_in, g_in, q_norm_g, k_norm_g, cmp_pe, cmp_w1, cmp_w2)
    x = x + gate1 * jnp.dot(jnp.concatenate([y_pool, y_nsa], axis=-1), w_out)
    h = rmsnorm(x, norm2_g) * (1.0 + scale2) + shift2
    x = x + gate2 * peer_ffn(h, w_pq, peer_keys, peer_u, peer_v)
    return x


def setup_inputs(seed: int = 0) -> dict:
    key = jax.random.key(seed)
    ks = jax.random.split(key, 19)

    def nrm(k, shape, scale):
        return jax.random.normal(k, shape, jnp.float32) * scale

    return {
        'x': nrm(ks[0], (BATCH, SEQ, D_MODEL), 1.0),
        'c': nrm(ks[1], (BATCH, D_MODEL), 1.0),
        'w_ada': nrm(ks[2], (DEPTH, D_MODEL, N_MOD * D_MODEL), D_MODEL ** -0.5),
        'b_ada': nrm(ks[3], (DEPTH, N_MOD * D_MODEL), 0.01),
        'norm1_g': 1.0 + nrm(ks[4], (DEPTH, D_MODEL), 0.01),
        'norm2_g': 1.0 + nrm(ks[5], (DEPTH, D_MODEL), 0.01),
        'w_in': nrm(ks[6], (DEPTH, D_MODEL, IN_WIDTH), D_MODEL ** -0.5),
        'w_out': nrm(ks[7], (DEPTH, MIX_WIDTH, D_MODEL), MIX_WIDTH ** -0.5),
        'w_pool': nrm(ks[8], (DEPTH, len(POOL_WINDOWS), POOL_GROUP, POOL_GROUP), POOL_GROUP ** -0.5),
        'pool_scale': 1.0 + nrm(ks[9], (DEPTH, POOL_WIDTH), 0.02),
        'q_norm_g': 1.0 + nrm(ks[10], (DEPTH, HEAD_DIM), 0.01),
        'k_norm_g': 1.0 + nrm(ks[11], (DEPTH, N_BRANCH, HEAD_DIM), 0.01),
        'cmp_pe': nrm(ks[12], (DEPTH, 2, CMP_BLOCK, HEAD_DIM), 0.02),
        'cmp_w1': nrm(ks[13], (DEPTH, 2, CMP_BLOCK, HEAD_DIM, CMP_HIDDEN), (CMP_BLOCK * HEAD_DIM) ** -0.5),
        'cmp_w2': nrm(ks[14], (DEPTH, 2, CMP_HIDDEN, HEAD_DIM), CMP_HIDDEN ** -0.5),
        'w_pq': nrm(ks[15], (DEPTH, D_MODEL, PEER_HEADS * PEER_KEY_DIM), D_MODEL ** -0.5),
        'peer_keys': nrm(ks[16], (DEPTH, PEER_HEADS, 2, PEER_NKEYS, PEER_KEY_DIM // 2), (PEER_KEY_DIM // 2) ** -0.5),
        'peer_u': nrm(ks[17], (DEPTH, PEER_EXPERTS, D_MODEL), D_MODEL ** -0.5),
        'peer_v': nrm(ks[18], (DEPTH, PEER_EXPERTS, D_MODEL), PEER_HEADS ** -0.5),
    }


def reference(x, c, w_ada, b_ada, norm1_g, norm2_g, w_in, w_out, w_pool, pool_scale,
              q_norm_g, k_norm_g, cmp_pe, cmp_w1, cmp_w2, w_pq, peer_keys, peer_u, peer_v):
    for l in range(DEPTH):
        x = hybrid_layer(x, c, w_ada[l], b_ada[l], norm1_g[l], norm2_g[l], w_in[l], w_out[l],
                         w_pool[l], pool_scale[l], q_norm_g[l], k_norm_g[l], cmp_pe[l], cmp_w1[l],
                         cmp_w2[l], w_pq[l], peer_keys[l], peer_u[l], peer_v[l])
    return x
```

```cpp
#include <hip/hip_runtime.h>
#include <math.h>
#include <stdint.h>

namespace {
constexpr int NB = 8, NT = 2048, DM = 4096, NTOK = NB * NT, INW = 7240;
constexpr int QOFF = 1024, KVOFF = 4096, GOFF = 7168, NCMP = 127, NMOD = 6 * DM;
constexpr float SCALE = 0.08838834764831845f;

__device__ __forceinline__ float wave_sum(float v) {
#pragma unroll
    for (int o = 32; o >= 1; o >>= 1) v += __shfl_xor(v, o);
    return v;
}
__device__ __forceinline__ float wave_max(float v) {
#pragma unroll
    for (int o = 32; o >= 1; o >>= 1) v = fmaxf(v, __shfl_xor(v, o));
    return v;
}
__device__ __forceinline__ float gelu_exact(float x) { return 0.5f * x * (1.0f + erff(x * 0.70710678118654752f)); }

__global__ void k_silu(const float* c, float* sc, int n) {
    int i = blockIdx.x * blockDim.x + threadIdx.x;
    if (i < n) { float v = c[i]; sc[i] = v / (1.0f + expf(-v)); }
}
__global__ void k_mod(const float* sc, const float* w_ada, const float* b_ada, float* mod) {
    int j = blockIdx.x * blockDim.x + threadIdx.x;
    int kz = blockIdx.y;
    float acc[NB];
#pragma unroll
    for (int b = 0; b < NB; ++b) acc[b] = 0.f;
    for (int k = kz * 256; k < kz * 256 + 256; ++k) {
        float w = w_ada[(size_t)k * NMOD + j];
#pragma unroll
        for (int b = 0; b < NB; ++b) acc[b] += sc[b * DM + k] * w;
    }
#pragma unroll
    for (int b = 0; b < NB; ++b) atomicAdd(&mod[b * NMOD + j], acc[b] + (kz == 0 ? b_ada[j] : 0.f));
}
__global__ void k_norm_mod(const float* x, const float* g, const float* mod, int shift_off, int scale_off, float* out) {
    int tok = blockIdx.x, b = tok / NT, tid = threadIdx.x;
    const float* xr = x + (size_t)tok * DM;
    float v[16]; float ss = 0.f;
#pragma unroll
    for (int i = 0; i < 4; ++i) { float4 a = *(const float4*)(xr + i * 1024 + tid * 4); v[i*4] = a.x; v[i*4+1] = a.y; v[i*4+2] = a.z; v[i*4+3] = a.w; ss += a.x*a.x + a.y*a.y + a.z*a.z + a.w*a.w; }
    __shared__ float red[4];
    ss = wave_sum(ss); if ((tid & 63) == 0) red[tid >> 6] = ss; __syncthreads();
    float tot = red[0] + red[1] + red[2] + red[3];
    float rstd = rsqrtf(tot / DM + 1e-6f);
    const float* sh = mod + (size_t)b * NMOD + shift_off; const float* sc = mod + (size_t)b * NMOD + scale_off;
#pragma unroll
    for (int i = 0; i < 4; ++i)
#pragma unroll
        for (int j = 0; j < 4; ++j) { int col = i * 1024 + tid * 4 + j; out[(size_t)tok * DM + col] = v[i*4+j] * rstd * g[col] * (1.0f + sc[col]) + sh[col]; }
}
__global__ __launch_bounds__(256) void k_gemm(const float* A, int lda, const float* Bm, int ldb, float* C, int ldc, int M, int N, int K) {
    __shared__ float As[16][68]; __shared__ float Bs[16][64];
    int bm = blockIdx.y * 64, bn = blockIdx.x * 64, tid = threadIdx.x, ty = tid >> 4, tx = tid & 15;
    float acc[4][4];
#pragma unroll
    for (int i = 0; i < 4; ++i)
#pragma unroll
        for (int j = 0; j < 4; ++j) acc[i][j] = 0.f;
    for (int k0 = 0; k0 < K; k0 += 16) {
        { int r = tid >> 2, c4 = (tid & 3) * 4; float4 a = *(const float4*)(A + (size_t)(bm + r) * lda + k0 + c4);
          As[c4][r] = a.x; As[c4+1][r] = a.y; As[c4+2][r] = a.z; As[c4+3][r] = a.w; }
        { int r = tid >> 4, c4 = (tid & 15) * 4; float4 b = make_float4(0.f, 0.f, 0.f, 0.f);
          if (bn + c4 < N) b = *(const float4*)(Bm + (size_t)(k0 + r) * ldb + bn + c4);
          *(float4*)&Bs[r][c4] = b; }
        __syncthreads();
#pragma unroll
        for (int kk = 0; kk < 16; ++kk) {
            float4 a = *(const float4*)&As[kk][ty * 4]; float4 b = *(const float4*)&Bs[kk][tx * 4];
            float av[4] = {a.x, a.y, a.z, a.w}, bv[4] = {b.x, b.y, b.z, b.w};
#pragma unroll
            for (int i = 0; i < 4; ++i)
#pragma unroll
                for (int j = 0; j < 4; ++j) acc[i][j] += av[i] * bv[j];
        }
        __syncthreads();
    }
    if (bn + tx * 4 < N) {
#pragma unroll
        for (int i = 0; i < 4; ++i) *(float4*)(C + (size_t)(bm + ty * 4 + i) * ldc + bn + tx * 4) = make_float4(acc[i][0], acc[i][1], acc[i][2], acc[i][3]);
    }
}
__global__ void k_pool_d(const float* proj, float* dpool) {
    int idx = blockIdx.x * blockDim.x + threadIdx.x; int tok = idx >> 10, c = idx & 1023; int t = tok % NT; int w = 2 << (c >> 8);
    int n = (t + 1 < w) ? t + 1 : w; float s = 0.f;
    for (int i = 0; i < n; ++i) s += proj[(size_t)(tok - i) * INW + c];
    dpool[idx] = s / (float)n - proj[(size_t)tok * INW + c];
}
__global__ void k_pool_scale(float* mix, const float* ps) {
    int idx = blockIdx.x * blockDim.x + threadIdx.x; int tok = idx >> 10, c = idx & 1023;
    mix[(size_t)tok * DM + c] *= ps[c];
}
__global__ void k_knorm_rope(const float* proj, const float* k_norm_g, float* ksel, float* kwin) {
    int tok = blockIdx.x, t = tok % NT, tid = threadIdx.x, w = tid >> 6, lane = tid & 63;
    for (int s = w; s < 8; s += 4) {
        int br = 1 + (s >> 2), g = s & 3;
        const float* src = proj + (size_t)tok * INW + KVOFF + ((br * 2 + 0) * 4 + g) * 128;
        float x1 = src[lane], x2 = src[64 + lane];
        float ss = wave_sum(x1 * x1 + x2 * x2); float rstd = rsqrtf(ss / 128.f + 1e-6f);
        float y1 = x1 * rstd * k_norm_g[br * 128 + lane], y2 = x2 * rstd * k_norm_g[br * 128 + 64 + lane];
        float inv = powf(10000.f, -(float)lane / 64.f); float ang = (float)t * inv; float sn, cs; sincosf(ang, &sn, &cs);
        float* dst = (br == 1 ? ksel : kwin) + ((size_t)tok * 4 + g) * 128;
        dst[lane] = y1 * cs - y2 * sn; dst[64 + lane] = y2 * cs + y1 * sn;
    }
}
__global__ __launch_bounds__(256) void k_cmp(const float* proj, const float* pe, const float* w1, const float* w2, const float* k_norm_g, float* cmp) {
    int id = blockIdx.x; int g = id & 3; id >>= 2; int n = id % NCMP; id /= NCMP; int b = id & 7; int kv = id >> 3;
    int tid = threadIdx.x;
    __shared__ float kb[4096]; __shared__ float hs[256]; __shared__ float red[2];
    int col = KVOFF + ((0 * 2 + kv) * 4 + g) * 128;
    for (int i = tid; i < 4096; i += 256) { int l = i >> 7, d = i & 127; kb[i] = proj[(size_t)(b * NT + 16 * n + l) * INW + col + d] + pe[kv * 4096 + i]; }
    __syncthreads();
    const float* w1p = w1 + (size_t)kv * 4096 * 256;
    float acc = 0.f;
    for (int i = 0; i < 4096; ++i) acc += kb[i] * w1p[(size_t)i * 256 + tid];
    hs[tid] = gelu_exact(acc);
    __syncthreads();
    float o = 0.f;
    if (tid < 128) { const float* w2p = w2 + (size_t)kv * 256 * 128; for (int h = 0; h < 256; ++h) o += hs[h] * w2p[h * 128 + tid]; }
    if (kv == 0) {
        float ss = (tid < 128) ? o * o : 0.f; ss = wave_sum(ss); if (tid < 128 && (tid & 63) == 0) red[tid >> 6] = ss; __syncthreads();
        float rstd = rsqrtf((red[0] + red[1]) / 128.f + 1e-6f); o = o * rstd * k_norm_g[0 * 128 + (tid & 127)];
    }
    if (tid < 128) cmp[((((size_t)kv * NB + b) * 128 + n) * 4 + g) * 128 + tid] = o;
}
__global__ __launch_bounds__(128) void k_attn_cmp(const float* proj, const float* q_norm_g, const float* cmp, float* mix, unsigned* selmask) {
    int tok = blockIdx.x >> 2, g = blockIdx.x & 3, b = tok / NT, t = tok % NT, tid = threadIdx.x, lane = tid & 63, w = tid >> 6;
    __shared__ float qs[6][128]; __shared__ float ps[6][128]; __shared__ float red[6][2]; __shared__ float red2[6][2]; __shared__ float scj[32];
    float qv[6];
#pragma unroll
    for (int r = 0; r < 6; ++r) { qv[r] = proj[(size_t)tok * INW + QOFF + (g * 6 + r) * 128 + tid]; float ss = wave_sum(qv[r] * qv[r]); if (lane == 0) red[r][w] = ss; }
    __syncthreads();
#pragma unroll
    for (int r = 0; r < 6; ++r) { float rstd = rsqrtf((red[r][0] + red[r][1]) / 128.f + 1e-6f); qs[r][tid] = qv[r] * rstd * q_norm_g[tid]; }
    __syncthreads();
    int nvalid = (t >= 31) ? ((t - 31) / 16 + 1) : 0; if (nvalid > NCMP) nvalid = NCMP;
    const float* kc = cmp + ((((size_t)0 * NB + b) * 128 + tid) * 4 + g) * 128;
    const float* vc = cmp + ((((size_t)1 * NB + b) * 128) * 4 + g) * 128;
    float s[6];
    bool act = tid < nvalid;
#pragma unroll
    for (int r = 0; r < 6; ++r) s[r] = -INFINITY;
    if (act) {
#pragma unroll
        for (int r = 0; r < 6; ++r) s[r] = 0.f;
        for (int d = 0; d < 128; ++d) { float kvv = kc[d];
#pragma unroll
            for (int r = 0; r < 6; ++r) s[r] += qs[r][d] * kvv; }
#pragma unroll
        for (int r = 0; r < 6; ++r) s[r] *= SCALE;
    }
#pragma unroll
    for (int r = 0; r < 6; ++r) { float m = wave_max(s[r]); if (lane == 0) red2[r][w] = m; }
    __syncthreads();
    float p[6];
#pragma unroll
    for (int r = 0; r < 6; ++r) { float m = fmaxf(red2[r][0], red2[r][1]); if (!(m > -INFINITY)) m = 0.f; p[r] = act ? expf(s[r] - m) : 0.f; float sm = wave_sum(p[r]); if (lane == 0) red[r][w] = sm; }
    __syncthreads();
#pragma unroll
    for (int r = 0; r < 6; ++r) { float den = red[r][0] + red[r][1]; ps[r][tid] = p[r] / (den > 0.f ? den : 1.0f); }
    __syncthreads();
    float o[6];
#pragma unroll
    for (int r = 0; r < 6; ++r) o[r] = 0.f;
    for (int n = 0; n < nvalid; ++n) { float vv = vc[(size_t)n * 512 + tid];
#pragma unroll
        for (int r = 0; r < 6; ++r) o[r] += ps[r][n] * vv; }
#pragma unroll
    for (int r = 0; r < 6; ++r) { float gc = proj[(size_t)tok * INW + GOFF + (g * 6 + r) * 3 + 0]; gc = 1.0f / (1.0f + expf(-gc)); mix[(size_t)tok * DM + 1024 + (g * 6 + r) * 128 + tid] = gc * o[r]; }
    if (tid < 32) {
        int j = tid; float imp = 0.f;
        for (int r = 0; r < 6; ++r) {
            for (int i = 0; i < 3; ++i) { int n = 4 * j + i; if (n < NCMP) imp += ps[r][n]; }
            { int n = 4 * j + 3; if (n < NCMP) imp += 0.5f * ps[r][n]; }
            { int n = 4 * j - 1; if (n >= 0) imp += 0.5f * ps[r][n]; }
        }
        int cur = t >> 6; bool forced = (j == 0) || (j == cur) || (j == cur - 1); bool valid = (j * 64) <= t;
        scj[j] = valid ? (imp + (forced ? 1000.f : 0.f)) : -1e9f;
    }
    __syncthreads();
    if (tid == 0) {
        unsigned mask = 0;
        for (int it = 0; it < 16; ++it) { float best = -INFINITY; int bi = 0;
            for (int j = 0; j < 32; ++j) if (!((mask >> j) & 1u) && scj[j] > best) { best = scj[j]; bi = j; }
            mask |= 1u << bi; }
        selmask[tok * 4 + g] = mask;
    }
}
__global__ __launch_bounds__(256) void k_attn_sw(const float* proj, const float* q_norm_g, const float* ksel, const float* kwin, const unsigned* selmask, float* mix) {
    int tok = blockIdx.x >> 2, g = blockIdx.x & 3, b = tok / NT, t = tok % NT, tid = threadIdx.x, lane = tid & 63, w = tid >> 6;
    __shared__ float qr[6][128]; __shared__ float sc[6][2048]; __shared__ float red[6][4]; __shared__ float osum[6][128];
    for (int r = w; r < 6; r += 4) {
        const float* src = proj + (size_t)tok * INW + QOFF + (g * 6 + r) * 128;
        float x1 = src[lane], x2 = src[64 + lane]; float ss = wave_sum(x1 * x1 + x2 * x2); float rstd = rsqrtf(ss / 128.f + 1e-6f);
        float y1 = x1 * rstd * q_norm_g[lane], y2 = x2 * rstd * q_norm_g[64 + lane];
        float inv = powf(10000.f, -(float)lane / 64.f); float ang = (float)t * inv; float sn, cs; sincosf(ang, &sn, &cs);
        qr[r][lane] = y1 * cs - y2 * sn; qr[r][64 + lane] = y2 * cs + y1 * sn;
    }
    __syncthreads();
    unsigned mask = selmask[tok * 4 + g];
    float oacc[6];
#pragma unroll
    for (int r = 0; r < 6; ++r) oacc[r] = 0.f;
    for (int br = 1; br <= 2; ++br) {
        const float* kbase = (br == 1 ? ksel : kwin);
        int klo = (br == 1) ? 0 : (t - 511 > 0 ? t - 511 : 0);
        float mx[6];
#pragma unroll
        for (int r = 0; r < 6; ++r) mx[r] = -INFINITY;
        for (int key = klo + tid; key <= t; key += 256) {
            bool act = (br == 1) ? ((mask >> (key >> 6)) & 1u) : true;
            float s[6];
            if (act) {
                const float* kr = kbase + ((size_t)(b * NT + key) * 4 + g) * 128;
#pragma unroll
                for (int r = 0; r < 6; ++r) s[r] = 0.f;
                for (int d = 0; d < 128; d += 4) { float4 kk = *(const float4*)(kr + d);
#pragma unroll
                    for (int r = 0; r < 6; ++r) s[r] += qr[r][d] * kk.x + qr[r][d+1] * kk.y + qr[r][d+2] * kk.z + qr[r][d+3] * kk.w; }
            }
#pragma unroll
            for (int r = 0; r < 6; ++r) { float v = act ? s[r] * SCALE : -INFINITY; sc[r][key] = v; mx[r] = fmaxf(mx[r], v); }
        }
#pragma unroll
        for (int r = 0; r < 6; ++r) { float m = wave_max(mx[r]); if (lane == 0) red[r][w] = m; }
        __syncthreads();
        float m6[6], sm[6];
#pragma unroll
        for (int r = 0; r < 6; ++r) { m6[r] = fmaxf(fmaxf(red[r][0], red[r][1]), fmaxf(red[r][2], red[r][3])); sm[r] = 0.f; }
        __syncthreads();
        for (int key = klo + tid; key <= t; key += 256) {
#pragma unroll
            for (int r = 0; r < 6; ++r) { float p = expf(sc[r][key] - m6[r]); sc[r][key] = p; sm[r] += p; }
        }
#pragma unroll
        for (int r = 0; r < 6; ++r) { float s2 = wave_sum(sm[r]); if (lane == 0) red[r][w] = s2; }
        __syncthreads();
        float den[6];
#pragma unroll
        for (int r = 0; r < 6; ++r) den[r] = red[r][0] + red[r][1] + red[r][2] + red[r][3];
        int d = tid & 127, half = tid >> 7;
        float o[6];
#pragma unroll
        for (int r = 0; r < 6; ++r) o[r] = 0.f;
        int vcol = KVOFF + ((br * 2 + 1) * 4 + g) * 128 + d;
        for (int key = klo + half; key <= t; key += 2) {
            if (br == 1 && !((mask >> (key >> 6)) & 1u)) continue;
            float vv = proj[(size_t)(b * NT + key) * INW + vcol];
#pragma unroll
            for (int r = 0; r < 6; ++r) o[r] += sc[r][key] * vv;
        }
        if (half == 1) {
#pragma unroll
            for (int r = 0; r < 6; ++r) osum[r][d] = o[r];
        }
        __syncthreads();
        if (half == 0) {
#pragma unroll
            for (int r = 0; r < 6; ++r) { float gt = proj[(size_t)tok * INW + GOFF + (g * 6 + r) * 3 + br]; gt = 1.0f / (1.0f + expf(-gt));
                oacc[r] += gt * (o[r] + osum[r][d]) / (den[r] > 0.f ? den[r] : 1.0f); }
        }
        __syncthreads();
    }
    if (tid < 128) {
#pragma unroll
        for (int r = 0; r < 6; ++r) mix[(size_t)tok * DM + 1024 + (g * 6 + r) * 128 + tid] += oacc[r];
    }
}
__global__ void k_resid(const float* x, const float* mod, int gate_off, const float* y, float* out) {
    size_t idx = (size_t)blockIdx.x * blockDim.x + threadIdx.x; int tok = (int)(idx >> 12), c = (int)(idx & 4095); int b = tok / NT;
    out[idx] = x[idx] + mod[(size_t)b * NMOD + gate_off + c] * y[idx];
}
__global__ __launch_bounds__(256) void k_peer_topk(const float* q, const float* keys, int* eidx, float* gw) {
    int tok = blockIdx.x, tid = threadIdx.x;
    __shared__ float qs[2048]; __shared__ float s[16][128]; __shared__ float tv[16][16]; __shared__ int ti[16][16]; __shared__ float cand[8][256];
    for (int i = tid; i < 2048; i += 256) qs[i] = q[(size_t)tok * 2048 + i];
    __syncthreads();
    for (int i = 0; i < 8; ++i) { int idx = tid + 256 * i; int list = idx >> 7, k = idx & 127; const float* kr = keys + ((size_t)list * 128 + k) * 128; const float* qq = qs + list * 128;
        float a = 0.f; for (int d = 0; d < 128; d += 4) { float4 kk = *(const float4*)(kr + d); a += qq[d] * kk.x + qq[d+1] * kk.y + qq[d+2] * kk.z + qq[d+3] * kk.w; }
        s[list][k] = a; }
    __syncthreads();
    if (tid < 16) { int list = tid;
        for (int it = 0; it < 16; ++it) { float best = -INFINITY; int bi = 0; for (int k = 0; k < 128; ++k) { float v = s[list][k]; if (v > best) { best = v; bi = k; } }
            tv[list][it] = best; ti[list][it] = bi; s[list][bi] = -INFINITY; } }
    __syncthreads();
    { int h = tid >> 5, l = tid & 31; for (int c = l; c < 256; c += 32) cand[h][c] = tv[2 * h][c >> 4] + tv[2 * h + 1][c & 15]; }
    __syncthreads();
    if (tid < 8) { int h = tid; float ts[16]; int te[16];
        for (int it = 0; it < 16; ++it) { float best = -INFINITY; int bi = 0; for (int c = 0; c < 256; ++c) { float v = cand[h][c]; if (v > best) { best = v; bi = c; } }
            ts[it] = best; te[it] = ti[2 * h][bi >> 4] * 128 + ti[2 * h + 1][bi & 15]; cand[h][bi] = -INFINITY; }
        float m = ts[0]; float den = 0.f; for (int it = 0; it < 16; ++it) { ts[it] = expf(ts[it] - m); den += ts[it]; }
        for (int it = 0; it < 16; ++it) { eidx[(size_t)tok * 128 + h * 16 + it] = te[it]; gw[(size_t)tok * 128 + h * 16 + it] = ts[it] / den; } }
}
__global__ __launch_bounds__(256) void k_peer_u(const float* h, const float* pu, const int* eidx, float* gw) {
    int tok = blockIdx.x, tid = threadIdx.x, lane = tid & 63, w = tid >> 6;
    float4 hv[16];
#pragma unroll
    for (int i = 0; i < 16; ++i) hv[i] = *(const float4*)(h + (size_t)tok * DM + i * 256 + lane * 4);
    for (int k = w; k < 128; k += 4) { int e = eidx[(size_t)tok * 128 + k]; const float* ur = pu + (size_t)e * DM; float a = 0.f;
#pragma unroll
        for (int i = 0; i < 16; ++i) { float4 u = *(const float4*)(ur + i * 256 + lane * 4); a += hv[i].x * u.x + hv[i].y * u.y + hv[i].z * u.z + hv[i].w * u.w; }
        a = wave_sum(a); if (lane == 0) gw[(size_t)tok * 128 + k] *= gelu_exact(a); }
}
__global__ __launch_bounds__(256) void k_peer_v(const float* pv, const int* eidx, const float* gw, const float* mod, float* out) {
    int tok = blockIdx.x, tid = threadIdx.x, b = tok / NT;
    float4 acc[4];
#pragma unroll
    for (int i = 0; i < 4; ++i) acc[i] = make_float4(0.f, 0.f, 0.f, 0.f);
    for (int k = 0; k < 128; ++k) { int e = eidx[(size_t)tok * 128 + k]; float wk = gw[(size_t)tok * 128 + k]; const float* vr = pv + (size_t)e * DM;
#pragma unroll
        for (int i = 0; i < 4; ++i) { float4 v = *(const float4*)(vr + i * 1024 + tid * 4); acc[i].x += wk * v.x; acc[i].y += wk * v.y; acc[i].z += wk * v.z; acc[i].w += wk * v.w; } }
    const float* g2 = mod + (size_t)b * NMOD + 5 * DM;
#pragma unroll
    for (int i = 0; i < 4; ++i) { int c = i * 1024 + tid * 4; float4 o = *(float4*)(out + (size_t)tok * DM + c); float4 gg = *(const float4*)(g2 + c);
        o.x += gg.x * acc[i].x; o.y += gg.y * acc[i].y; o.z += gg.z * acc[i].z; o.w += gg.w * acc[i].w; *(float4*)(out + (size_t)tok * DM + c) = o; }
}
}

extern "C" void kernel_launch(void* const* d_in, const int* in_sizes, int n_in, void* d_out, int out_size, void* d_ws, size_t ws_size, hipStream_t stream) {
    const float* x = (const float*)d_in[0]; const float* c = (const float*)d_in[1]; const float* w_ada = (const float*)d_in[2]; const float* b_ada = (const float*)d_in[3];
    const float* norm1_g = (const float*)d_in[4]; const float* norm2_g = (const float*)d_in[5]; const float* w_in = (const float*)d_in[6]; const float* w_out = (const float*)d_in[7];
    const float* w_pool = (const float*)d_in[8]; const float* pool_scale = (const float*)d_in[9]; const float* q_norm_g = (const float*)d_in[10]; const float* k_norm_g = (const float*)d_in[11];
    const float* cmp_pe = (const float*)d_in[12]; const float* cmp_w1 = (const float*)d_in[13]; const float* cmp_w2 = (const float*)d_in[14]; const float* w_pq = (const float*)d_in[15];
    const float* peer_keys = (const float*)d_in[16]; const float* peer_u = (const float*)d_in[17]; const float* peer_v = (const float*)d_in[18];
    float* out = (float*)d_out;
    char* ws = (char*)d_ws; size_t off = 0;
    auto take = [&](size_t bytes) { char* p = ws + off; off += (bytes + 255) & ~(size_t)255; return p; };
    float* sc = (float*)take((size_t)NB * DM * 4);
    float* mod = (float*)take((size_t)NB * NMOD * 4);
    float* hbuf = (float*)take((size_t)NTOK * DM * 4);
    float* proj = (float*)take((size_t)NTOK * INW * 4);
    float* mix = (float*)take((size_t)NTOK * DM * 4);
    float* dpool = (float*)take((size_t)NTOK * 1024 * 4);
    float* ksel = (float*)take((size_t)NTOK * 512 * 4);
    float* kwin = (float*)take((size_t)NTOK * 512 * 4);
    float* cmpb = (float*)take((size_t)2 * NB * 128 * 4 * 128 * 4);
    unsigned* selmask = (unsigned*)take((size_t)NTOK * 4 * 4);
    int* eidx = (int*)take((size_t)NTOK * 128 * 4);
    float* gw = (float*)take((size_t)NTOK * 128 * 4);
    float* tmp = proj;
    float* qpeer = proj;
    (void)ws_size; (void)in_sizes; (void)n_in; (void)out_size;

    k_silu<<<(NB * DM + 255) / 256, 256, 0, stream>>>(c, sc, NB * DM);
    hipMemsetAsync(mod, 0, (size_t)NB * NMOD * 4, stream);
    k_mod<<<dim3(NMOD / 256, 16), 256, 0, stream>>>(sc, w_ada, b_ada, mod);
    k_norm_mod<<<NTOK, 256, 0, stream>>>(x, norm1_g, mod, 0 * DM, 1 * DM, hbuf);
    k_gemm<<<dim3((INW + 63) / 64, NTOK / 64), 256, 0, stream>>>(hbuf, DM, w_in, INW, proj, INW, NTOK, INW, DM);
    k_pool_d<<<NTOK * 1024 / 256, 256, 0, stream>>>(proj, dpool);
    for (int gi = 0; gi < 4; ++gi)
        k_gemm<<<dim3(4, NTOK / 64), 256, 0, stream>>>(dpool + gi * 256, 1024, w_pool + (size_t)gi * 65536, 256, mix + gi * 256, DM, NTOK, 256, 256);
    k_pool_scale<<<NTOK * 1024 / 256, 256, 0, stream>>>(mix, pool_scale);
    k_knorm_rope<<<NTOK, 256, 0, stream>>>(proj, k_norm_g, ksel, kwin);
    k_cmp<<<2 * NB * NCMP * 4, 256, 0, stream>>>(proj, cmp_pe, cmp_w1, cmp_w2, k_norm_g, cmpb);
    k_attn_cmp<<<NTOK * 4, 128, 0, stream>>>(proj, q_norm_g, cmpb, mix, selmask);
    k_attn_sw<<<NTOK * 4, 256, 0, stream>>>(proj, q_norm_g, ksel, kwin, selmask, mix);
    k_gemm<<<dim3(DM / 64, NTOK / 64), 256, 0, stream>>>(mix, DM, w_out, DM, tmp, DM, NTOK, DM, DM);
    k_resid<<<(unsigned)((size_t)NTOK * DM / 256), 256, 0, stream>>>(x, mod, 2 * DM, tmp, out);
    k_norm_mod<<<NTOK, 256, 0, stream>>>(out, norm2_g, mod, 3 * DM, 4 * DM, hbuf);
    k_gemm<<<dim3(2048 / 64, NTOK / 64), 256, 0, stream>>>(hbuf, DM, w_pq, 2048, qpeer, 2048, NTOK, 2048, DM);
    k_peer_topk<<<NTOK, 256, 0, stream>>>(qpeer, peer_keys, eidx, gw);
    k_peer_u<<<NTOK, 256, 0, stream>>>(hbuf, peer_u, eidx, gw);
    k_peer_v<<<NTOK, 256, 0, stream>>>(peer_v, eidx, gw, mod, out);
}
```

```cpp
#include <hip/hip_runtime.h>
#include <math.h>
#include <stdint.h>
#include <stdio.h>

#define LAS __attribute__((address_space(3)))
typedef unsigned short bf16_t;
typedef float f4 __attribute__((ext_vector_type(4)));
namespace {
constexpr int NB = 8, NT = 2048, DM = 4096, NTOK = NB * NT, INW = 7240, PLD = 7424;
constexpr int QOFF = 1024, KVOFF = 4096, GOFF = 7168, NCMP = 127, NMOD = 6 * DM;
constexpr float SCALE = 0.08838834764831845f;
constexpr int NTHR = 512, NWAVES = 8;
constexpr int LDS_BYTES = 147456;
constexpr int LDS_XBW = LDS_BYTES - 64;

__device__ __forceinline__ float bf2f(bf16_t v) { return __uint_as_float(((unsigned)v) << 16); }
__device__ __forceinline__ bf16_t f2bf(float f) { unsigned u = __float_as_uint(f); u += 0x7FFFu + ((u >> 16) & 1u); return (bf16_t)(u >> 16); }
__device__ __forceinline__ unsigned pk_bf16(float lo, float hi) { unsigned r; asm volatile("v_cvt_pk_bf16_f32 %0, %1, %2" : "=v"(r) : "v"(lo), "v"(hi)); return r; }
__device__ __forceinline__ float wave_sum(float v) {
#pragma unroll
    for (int o = 32; o >= 1; o >>= 1) v += __shfl_xor(v, o);
    return v;
}
__device__ __forceinline__ float wave_max(float v) {
#pragma unroll
    for (int o = 32; o >= 1; o >>= 1) v = fmaxf(v, __shfl_xor(v, o));
    return v;
}
__device__ __forceinline__ float gelu_exact(float x) { return 0.5f * x * (1.0f + erff(x * 0.70710678118654752f)); }
}
namespace pg8 {
#define PG8_LAS __attribute__((address_space(3)))
typedef unsigned short bf16_t;
typedef short bf16x8 __attribute__((ext_vector_type(8)));
typedef float f32x4 __attribute__((ext_vector_type(4)));
typedef unsigned u32x4 __attribute__((ext_vector_type(4)));
typedef int pg8_i4 __attribute__((ext_vector_type(4)));
typedef int pg8_i8 __attribute__((ext_vector_type(8)));
constexpr int BM = 256, BK = 64, HALF = 128, HTB = HALF * BK * 2  , STAGE_BYTES = 8 * HTB, NXCD = 8, WGM = 8;

__host__ __device__ __forceinline__ int lds_byte(int r, int c) { const int st = (r >> 4) * 2 + (c >> 5), rr = r & 15, cc = c & 31, ob = rr * 64 + cc * 2; return st * 1024 + (ob ^ (((ob >> 9) & 1) << 5)); }
__host__ __device__ __forceinline__ void stage_rc(int b, int& R, int& C) { const int st = b / 1024, sb = b % 1024, swz = sb ^ (((sb >> 9) & 1) << 5); R = (st >> 1) * 16 + swz / 64; C = (st & 1) * 32 + (swz % 64) / 2; }
__host__ __device__ __forceinline__ int perm32(int rho) { const int n = rho >> 4, i = rho & 15; return 8 * (i >> 2) + 4 * n + (i & 3); }

struct Unit { int pm, pn; };
struct Gemm { const bf16_t* A; const bf16_t* Bt; int M, N, K; };

struct StaticOrder {
    int nM, nN, nwg, G, c;
    __host__ __device__ void init(int M, int N, int G_, int c_) { nM = M / BM; nN = N / BM; nwg = nM * nN; G = G_; c = c_; }
    __host__ __device__ bool next(int i, Unit& u) const {
        const long L = (long)i * G + c; if (L >= nwg) return false;
        int wgid = (int)L; { const int q = nwg / NXCD, r = nwg % NXCD, xcd = wgid % NXCD, off = wgid / NXCD; wgid = (xcd < r ? xcd * (q + 1) : r * (q + 1) + (xcd - r) * q) + off; }
        const int nig = WGM * nN, gid = wgid / nig, fm = gid * WGM, gsz = (nM - fm) < WGM ? (nM - fm) : WGM;
        u.pm = fm + ((wgid % nig) % gsz); u.pn = (wgid % nig) / gsz; return true;
    }
    __device__ __forceinline__ void a_ready(const Unit&) const {}
    __device__ __forceinline__ void done(const Unit&) const {}
};
__device__ __forceinline__ unsigned cvt_pk_bf16(float lo, float hi) { unsigned r; asm volatile("v_cvt_pk_bf16_f32 %0, %1, %2" : "=v"(r) : "v"(lo), "v"(hi)); return r; }
typedef float f32x2 __attribute__((ext_vector_type(2)));
__device__ __forceinline__ f32x2 gelu_pk(f32x2 v) {
    const f32x2 av = __builtin_elementwise_abs(v), d = av * 0.2316418882f + 1.0f;
    f32x2 t; t.x = __builtin_amdgcn_rcpf(d.x); t.y = __builtin_amdgcn_rcpf(d.y);
    f32x2 q = t * 0.5307027145f + (-0.7265760135f); q = q * t + 0.7107068705f; q = q * t + (-0.142248368f); q = q * t + 0.127414796f; q = q * t;
    const f32x2 s = (v * v) * (-0.72134752044f);
    f32x2 e; e.x = __builtin_amdgcn_exp2f(s.x); e.y = __builtin_amdgcn_exp2f(s.y);
    const f32x2 m = v * (q * e), r = v - m;
    f32x2 o; o.x = v.x < 0.f ? m.x : r.x; o.y = v.y < 0.f ? m.y : r.y; return o;
}

template <int ACT  > struct EpiBf16 {
    static constexpr bool PERM = true, AFTER_DRAIN = false;
    bf16_t* O; int ldc; const float* bias; int split_cols; size_t split_stride;
    __device__ __forceinline__ void operator()(const f32x4 (&acc)[2][2][4][2], const Unit& u, int wr, int wc, int fr, int fq) const {
        const int row0 = u.pm * BM + wr * 64 + fr; int colt = u.pn * BM; bf16_t* base = O;
        if (split_cols) { const int t = colt / split_cols; base += (size_t)t * split_stride; colt -= t * split_cols; }
        const int col0 = colt + wc * 32 + 8 * fq, bcol0 = u.pn * BM + wc * 32 + 8 * fq;
        f32x4 bv[2][2];
#pragma unroll
        for (int bj = 0; bj < 2; ++bj)
#pragma unroll
            for (int n = 0; n < 2; ++n) bv[bj][n] = bias ? *(const f32x4*)(bias + bcol0 + bj * HALF + 4 * n) : (f32x4){0.f, 0.f, 0.f, 0.f};
#pragma unroll
        for (int ai = 0; ai < 2; ++ai)
#pragma unroll
            for (int m = 0; m < 4; ++m) { bf16_t* rowp = base + (size_t)(row0 + ai * HALF + m * 16) * ldc + col0;
#pragma unroll
                for (int bj = 0; bj < 2; ++bj) { f32x4 v0 = acc[ai][bj][m][0] + bv[bj][0], v1 = acc[ai][bj][m][1] + bv[bj][1];
                    if (ACT == 1) { f32x2 a = gelu_pk((f32x2){v0[0], v0[1]}), b = gelu_pk((f32x2){v0[2], v0[3]}), c = gelu_pk((f32x2){v1[0], v1[1]}), d = gelu_pk((f32x2){v1[2], v1[3]});
                        v0 = (f32x4){a.x, a.y, b.x, b.y}; v1 = (f32x4){c.x, c.y, d.x, d.y}; }
                    if (ACT == 2) {
#pragma unroll
                        for (int j = 0; j < 4; ++j) { v0[j] = 0.5f * v0[j] * (1.0f + erff(v0[j] * 0.70710678f)); v1[j] = 0.5f * v1[j] * (1.0f + erff(v1[j] * 0.70710678f)); } }
                    u32x4 w; w.x = cvt_pk_bf16(v0[0], v0[1]); w.y = cvt_pk_bf16(v0[2], v0[3]); w.z = cvt_pk_bf16(v1[0], v1[1]); w.w = cvt_pk_bf16(v1[2], v1[3]);
                    *(u32x4*)(rowp + bj * HALF) = w; } }
    }
};
template <class Epi, class Sched, bool STAMP = false, bool FP8 = false, int NBF = 0>
__device__ __forceinline__ void gemm_phase(PG8_LAS unsigned char* lds, const Gemm g, const Sched& S, const Epi& E, unsigned long long* stamps) {
    const int tid = threadIdx.x, wid = __builtin_amdgcn_readfirstlane(tid >> 6), lane = tid & 63, wr = wid >> 2, wc = wid & 3, fr = lane & 15, fq = lane >> 4;
    const int K = g.K, nt = K / BK;
    int ts_lo = 0, ts_hi = 0, nts = 0; const unsigned long long rt_entry = STAMP ? (unsigned long long)wall_clock64() : 0ull;
#define PG8_STAMP() do { if (STAMP && wid == 0 && nts < 64) { const unsigned long long _c = (unsigned long long)clock64(); \
        ts_lo = (lane == nts) ? (int)(unsigned)_c : ts_lo; ts_hi = (lane == nts) ? (int)(unsigned)(_c >> 32) : ts_hi; ++nts; } } while (0)
    PG8_STAMP();
    unsigned voffA[2], voffB[2];
#pragma unroll
    for (int i = 0; i < 2; ++i) { int R, C; stage_rc(tid * 16 + i * 8192, R, C); const int Rb = Epi::PERM ? ((R & ~31) + perm32(R & 31)) : R;
        voffA[i] = (unsigned)(R * K + C) * 2u; voffB[i] = (unsigned)(Rb * K + C) * 2u; }
    const size_t kstep = (size_t)(BK * 2);
    const size_t hstep = (size_t)HALF * K * 2;
    const size_t tstep = 2 * hstep;
    const unsigned ldsw = (unsigned)wid * 1024u;
    const int aoff = lds_byte(wr * 64 + fr, fq * 8), boff = lds_byte(wc * 32 + fr, fq * 8);
#define PG8_SA(b, h) (((b) * 2 + (h)) * HTB)
#define PG8_SB(b, h) ((4 + (b) * 2 + (h)) * HTB)
#define PG8_STAGE(bufoff, gbase, voff) do { _Pragma("unroll") for (int _i = 0; _i < 2; ++_i) \
        __builtin_amdgcn_global_load_lds((const unsigned*)((const char*)(gbase) + (voff)[_i]), (PG8_LAS unsigned*)(lds + (bufoff) + ldsw + _i * 8192), 16, 0, 0); } while (0)
#define PG8_LDA(F, dst, b, h) do { _Pragma("unroll") for (int m = 0; m < 4; ++m) { if constexpr (F) { dst##8[m] = PG8_CAT(*(const PG8_LAS bf16x8*)(lds + PG8_SA(b, h) + aoff + m * 2048), *(const PG8_LAS bf16x8*)(lds + PG8_SA(b, h) + aoff + m * 2048 + 1024)); } \
        else { _Pragma("unroll") for (int k = 0; k < 2; ++k) dst[m][k] = *(const PG8_LAS bf16x8*)(lds + PG8_SA(b, h) + aoff + m * 2048 + k * 1024); } } } while (0)
#define PG8_LDB(F, dst, b, h) do { _Pragma("unroll") for (int n = 0; n < 2; ++n) { if constexpr (F) { dst##8[n] = PG8_CAT(*(const PG8_LAS bf16x8*)(lds + PG8_SB(b, h) + boff + n * 2048), *(const PG8_LAS bf16x8*)(lds + PG8_SB(b, h) + boff + n * 2048 + 1024)); } \
        else { _Pragma("unroll") for (int k = 0; k < 2; ++k) dst[n][k] = *(const PG8_LAS bf16x8*)(lds + PG8_SB(b, h) + boff + n * 2048 + k * 1024); } } } while (0)
#define PG8_CAT(x, y) __builtin_shufflevector(__builtin_bit_cast(pg8_i4, x), __builtin_bit_cast(pg8_i4, y), 0, 1, 2, 3, 4, 5, 6, 7)
#define PG8_MMA(F, ai, bj, At, Bt) do { __builtin_amdgcn_s_setprio(1); _Pragma("unroll") for (int m = 0; m < 4; ++m) _Pragma("unroll") for (int n = 0; n < 2; ++n) { \
        if constexpr (F) { asm("v_mfma_scale_f32_16x16x128_f8f6f4 %0, %1, %2, %0, %3, %3 op_sel_hi:[0,0,0]" : "+v"(acc[ai][bj][m][n]) : "v"(Bt##8[n]), "v"(At##8[m]), "v"(sc127)); } \
        else { _Pragma("unroll") for (int k = 0; k < 2; ++k) acc[ai][bj][m][n] = __builtin_amdgcn_mfma_f32_16x16x32_bf16(Bt[n][k], At[m][k], acc[ai][bj][m][n], 0, 0, 0); } } __builtin_amdgcn_s_setprio(0); } while (0)
#define PG8_WAIT_V(n) asm volatile("s_waitcnt vmcnt(" #n ")" ::: "memory")
#define PG8_WAIT_L(n) asm volatile("s_waitcnt lgkmcnt(" #n ")" ::: "memory")
#define PG8_BAR __builtin_amdgcn_s_barrier()
#define PG8_SCHED __builtin_amdgcn_sched_barrier(0)
#define PG8_KBODY(F) do { \
            const bool last = (t == nt - 2); \
            const char* a1 = cA + (size_t)(t + 1) * kstep; \
            const char* a2 = last ? nA : cA + (size_t)(t + 2) * kstep; const char* b2 = last ? nB : cB + (size_t)(t + 2) * kstep; \
            const char* a3 = a2 + kstep; const char* b3 = b2 + kstep; \
            if (last && has_next) S.a_ready(nxt); \
            PG8_LDB(F, B0, 0, 0); PG8_SCHED; PG8_LDA(F, At, 0, 0); PG8_STAGE(PG8_SA(1, 1), a1 + hstep, voffA); \
            PG8_WAIT_L(8); PG8_BAR; PG8_WAIT_L(0); PG8_MMA(F, 0, 0, At, B0); PG8_BAR; PG8_SCHED; \
            PG8_LDB(F, B1, 0, 1); PG8_STAGE(PG8_SB(0, 0), b2, voffB); \
            PG8_BAR; PG8_WAIT_L(0); PG8_MMA(F, 0, 1, At, B1); PG8_BAR; \
            PG8_LDA(F, At, 0, 1); PG8_STAGE(PG8_SA(0, 0), a2, voffA); \
            PG8_BAR; PG8_WAIT_L(0); PG8_MMA(F, 1, 0, At, B0); PG8_BAR; PG8_SCHED; \
            PG8_STAGE(PG8_SB(0, 1), b2 + hstep, voffB); \
            PG8_WAIT_V(6); PG8_BAR; PG8_MMA(F, 1, 1, At, B1); PG8_BAR; \
            PG8_LDB(F, B0, 1, 0); PG8_SCHED; PG8_LDA(F, At, 1, 0); PG8_STAGE(PG8_SA(0, 1), a2 + hstep, voffA); \
            PG8_WAIT_L(8); PG8_BAR; PG8_WAIT_L(0); PG8_MMA(F, 0, 0, At, B0); PG8_BAR; PG8_SCHED; \
            PG8_LDB(F, B1, 1, 1); PG8_STAGE(PG8_SB(1, 0), b3, voffB); \
            PG8_BAR; PG8_WAIT_L(0); PG8_MMA(F, 0, 1, At, B1); PG8_BAR; \
            PG8_LDA(F, At, 1, 1); PG8_STAGE(PG8_SA(1, 0), a3, voffA); \
            PG8_BAR; PG8_WAIT_L(0); PG8_MMA(F, 1, 0, At, B0); PG8_BAR; PG8_SCHED; \
            PG8_STAGE(PG8_SB(1, 1), b3 + hstep, voffB); \
            PG8_WAIT_V(6); PG8_BAR; PG8_MMA(F, 1, 1, At, B1); PG8_BAR; \
        } while (0)
    Unit cur, nxt; int ui = 0;
    if (!S.next(0, cur)) return;
    f32x4 acc[2][2][4][2];
#pragma unroll
    for (int a = 0; a < 2; ++a)
#pragma unroll
        for (int b = 0; b < 2; ++b)
#pragma unroll
            for (int m = 0; m < 4; ++m)
#pragma unroll
                for (int n = 0; n < 2; ++n) acc[a][b][m][n] = (f32x4){0.f, 0.f, 0.f, 0.f};
    bf16x8 At[4][2], B0[2][2], B1[2][2]; pg8_i8 At8[4], B08[2], B18[2]; int sc127 = 127; asm volatile("" : "+v"(sc127));
    const char* cA = (const char*)g.A + (size_t)cur.pm * tstep; const char* cB = (const char*)g.Bt + (size_t)cur.pn * tstep;
    S.a_ready(cur);
    PG8_STAGE(PG8_SB(0, 0), cB, voffB); PG8_STAGE(PG8_SA(0, 0), cA, voffA); PG8_STAGE(PG8_SB(0, 1), cB + hstep, voffB); PG8_STAGE(PG8_SA(0, 1), cA + hstep, voffA);
    if (wr == 1) PG8_BAR;
    PG8_WAIT_V(4); PG8_BAR;
    PG8_STAGE(PG8_SB(1, 0), cB + kstep, voffB); PG8_STAGE(PG8_SA(1, 0), cA + kstep, voffA); PG8_STAGE(PG8_SB(1, 1), cB + hstep + kstep, voffB);
    PG8_WAIT_V(6); PG8_BAR;
    PG8_STAMP();
    for (;;) {
        const bool has_next = S.next(ui + 1, nxt);
        const char* nA = has_next ? (const char*)g.A + (size_t)nxt.pm * tstep : cA; const char* nB = has_next ? (const char*)g.Bt + (size_t)nxt.pn * tstep : cB;
        { int t = 0;
          if constexpr (FP8 && NBF > 0) { for (; t < NBF; t += 2) PG8_KBODY(false); }
          for (; t < nt; t += 2) PG8_KBODY(FP8); }
        PG8_STAMP();
        if constexpr (FP8) { asm volatile("s_nop 15\n\ts_nop 15" ::: "memory"); }
        if constexpr (!Epi::AFTER_DRAIN) { E(acc, cur, wr, wc, fr, fq); S.done(cur); }
        PG8_STAMP();
        if (!has_next) break;
#pragma unroll
        for (int a = 0; a < 2; ++a)
#pragma unroll
            for (int b = 0; b < 2; ++b)
#pragma unroll
                for (int m = 0; m < 4; ++m)
#pragma unroll
                    for (int n = 0; n < 2; ++n) acc[a][b][m][n] = (f32x4){0.f, 0.f, 0.f, 0.f};
        cur = nxt; cA = nA; cB = nB; ++ui;
    }
    PG8_WAIT_V(0);
    if (wr == 0) PG8_BAR;
    PG8_BAR;
    if constexpr (Epi::AFTER_DRAIN) { E.fused(acc, cur, wr, wc, fr, fq, lds, wid, lane); S.done(cur); }
    PG8_STAMP();
    if (STAMP && wid == 0) { stamps[lane] = lane < nts ? (((unsigned long long)(unsigned)ts_hi << 32) | (unsigned)ts_lo) : 0ull;
        if (lane == 62) stamps[62] = rt_entry; if (lane == 63) stamps[63] = (unsigned long long)wall_clock64(); }
#undef PG8_STAMP
#undef PG8_SA
#undef PG8_SB
#undef PG8_STAGE
#undef PG8_LDA
#undef PG8_LDB
#undef PG8_MMA
#undef PG8_KBODY
#undef PG8_CAT
#undef PG8_WAIT_V
#undef PG8_WAIT_L
#undef PG8_BAR
#undef PG8_SCHED
}
}
#define XB_TMO      128
#define XB_XCNT(j)  (256  + 64 * (j))
#define XB_XSUB(j)  (1280 + 64 * (j))
#define XB_XGEN(j)  (2304 + 64 * (j))
#define XB_TOP      3328
#define XB_TOPGEN   3392
#define XCD_BAR_WORDS 3456
#define XB_SPIN_CAP (1u << 18)

__device__ __forceinline__ unsigned xb_ld(unsigned* p)              { return __hip_atomic_load(p, __ATOMIC_RELAXED, __HIP_MEMORY_SCOPE_AGENT); }
__device__ __forceinline__ unsigned xb_add(unsigned* p, unsigned v) { return __hip_atomic_fetch_add(p, v, __ATOMIC_RELAXED, __HIP_MEMORY_SCOPE_AGENT); }
__device__ __forceinline__ unsigned xb_xcc_id() { return (unsigned)__builtin_amdgcn_s_getreg((3 << 11) | 20) & 0xFu; }
#define XB_SPIN(cond, bar) do { unsigned _sp = 0; while (cond) { __builtin_amdgcn_s_sleep(1); \
    if ((++_sp & 255u) == 0u) { if (xb_ld(&(bar)[XB_TMO])) break; if (_sp > XB_SPIN_CAP) { atomicAdd(&(bar)[XB_TMO], 1u); break; } } } } while (0)

struct XcdBarrier {
    unsigned* bar; unsigned x;
    volatile LAS unsigned* st;
};

__device__ __forceinline__ XcdBarrier xcd_barrier_post(unsigned* bar, volatile LAS unsigned* st) {
    XcdBarrier b; b.bar = bar; b.x = xb_xcc_id(); b.st = st;
    if (threadIdx.x == 0) (void)xb_add(&bar[XB_XCNT(b.x)], 1u);
    return b;
}
__device__ __forceinline__ void xcd_barrier_complete(unsigned* bar, unsigned x, unsigned& nloc, unsigned& nx) {
    const unsigned G = gridDim.x * gridDim.y * gridDim.z;
    unsigned sum, cnt, mine, sp = 0u;
    for (;;) {
        sum = 0u; cnt = 0u; mine = 0u;
#pragma unroll
        for (unsigned j = 0; j < 16; ++j) { const unsigned c = xb_ld(&bar[XB_XCNT(j)]); sum += c; cnt += (c > 0u) ? 1u : 0u; mine = (j == x) ? c : mine; }
        if (sum == G) break;
        __builtin_amdgcn_s_sleep(1);
        if ((++sp & 255u) == 0u) { if (xb_ld(&bar[XB_TMO])) break; if (sp > XB_SPIN_CAP) { atomicAdd(&bar[XB_TMO], 1u); break; } }
    }
    nloc = mine > 0u ? mine : 1u; nx = cnt > 0u ? cnt : 1u;
}

__device__ __forceinline__ void xcd_barrier(const XcdBarrier& b) {
    asm volatile("s_waitcnt vmcnt(0)" ::: "memory");
    __syncthreads();
    if (threadIdx.x == 0) {
        unsigned* bar = b.bar;
        __builtin_amdgcn_s_waitcnt(0);
        unsigned nloc = b.st[0], nx = b.st[1];
        if (nloc == 0u) { xcd_barrier_complete(bar, b.x, nloc, nx); b.st[0] = nloc; b.st[1] = nx; }
        const unsigned old = xb_add(&bar[XB_XSUB(b.x)], 1u);
        const unsigned gen = old / nloc;
        if (old + 1u == (gen + 1u) * nloc) {
            __builtin_amdgcn_fence(__ATOMIC_RELEASE, "agent");
            asm volatile("s_waitcnt vmcnt(0)" ::: "memory");
            const unsigned og = xb_add(&bar[XB_TOP], 1u);
            const unsigned tg = og / nx;
            if (og + 1u == (tg + 1u) * nx) xb_add(&bar[XB_TOPGEN], 1u);
            else XB_SPIN(xb_ld(&bar[XB_TOPGEN]) == tg, bar);
            __builtin_amdgcn_fence(__ATOMIC_ACQUIRE, "agent");
            xb_add(&bar[XB_XGEN(b.x)], 1u);
            asm volatile("s_waitcnt vmcnt(0)" ::: "memory");
        } else {
            XB_SPIN(xb_ld(&bar[XB_XGEN(b.x)]) == gen, bar);
            __builtin_amdgcn_fence(__ATOMIC_ACQUIRE, "agent");
            asm volatile("s_waitcnt vmcnt(0)" ::: "memory");
        }
    }
    __syncthreads();
}
namespace {
struct EpiResid {
    static constexpr bool PERM = false, AFTER_DRAIN = false;
    const float* X; float* C; int ldc; const float* gate;
    __device__ __forceinline__ void operator()(const pg8::f32x4 (&acc)[2][2][4][2], const pg8::Unit& u, int wr, int wc, int fr, int fq) const {
        using pg8::f32x4; using pg8::HALF; using pg8::BM;
        const int row0 = u.pm * BM + wr * 64 + fr, col0 = u.pn * BM + wc * 32 + 4 * fq;
        const float* gp = gate + (size_t)(u.pm >> 3) * NMOD;
        f32x4 gv[2][2];
#pragma unroll
        for (int bj = 0; bj < 2; ++bj)
#pragma unroll
            for (int n = 0; n < 2; ++n) gv[bj][n] = *(const f32x4*)(gp + col0 + bj * HALF + n * 16);
#pragma unroll
        for (int ai = 0; ai < 2; ++ai)
#pragma unroll
            for (int m = 0; m < 4; ++m) { const size_t off = (size_t)(row0 + ai * HALF + m * 16) * ldc + col0;
#pragma unroll
                for (int bj = 0; bj < 2; ++bj)
#pragma unroll
                    for (int n = 0; n < 2; ++n) { const f32x4 xv = *(const f32x4*)(X + off + bj * HALF + n * 16); *(f32x4*)(C + off + bj * HALF + n * 16) = xv + gv[bj][n] * acc[ai][bj][m][n]; }
                asm volatile("" ::: "memory"); }
    }
};

struct Args {
    const float* in[19]; float* out; unsigned char* ws; int ph_lo, ph_hi, li, pad;
};
constexpr size_t WS_CTL = 0;
constexpr size_t WS_MOD = 65536;
constexpr size_t WS_WINT = WS_MOD + (size_t)NB * NMOD * 4;
constexpr size_t WS_WOUTT = WS_WINT + (size_t)PLD * DM * 2;
constexpr size_t WS_WPQT = WS_WOUTT + (size_t)DM * DM * 2;
constexpr size_t WS_H = WS_WPQT + (size_t)2048 * DM * 2;
constexpr size_t WS_PROJ = WS_H + (size_t)NTOK * DM * 2;
constexpr size_t WS_MIX = WS_PROJ + (size_t)NTOK * PLD * 2;
constexpr size_t WS_QP = WS_MIX + (size_t)NTOK * DM * 2;
constexpr size_t WS_END_A = WS_QP + (size_t)NTOK * 2048 * 2;

constexpr int MOD_KS = 21;
__device__ __forceinline__ void p0_mod(const float* c, const float* w_ada, float* part, LAS unsigned char* lds, int blk) {
    const int tid = threadIdx.x;
    if (blk >= 12 * MOD_KS) return;
    const int cs = blk % 12, ks = blk / 12, kbeg = ks * 196, kend = (kbeg + 196 < DM) ? kbeg + 196 : DM, nk = kend - kbeg;
    LAS float* sc = (LAS float*)lds;
    for (int i = tid; i < nk * 8; i += NTHR) { const int b = i & 7, k = kbeg + (i >> 3); const float v = c[b * DM + k]; sc[i] = v / (1.0f + __expf(-v)); }
    __syncthreads();
    const int col = cs * 2048 + tid * 4;
    float acc[NB][4];
#pragma unroll
    for (int b = 0; b < NB; ++b)
#pragma unroll
        for (int j = 0; j < 4; ++j) acc[b][j] = 0.f;
    const float* wp = w_ada + (size_t)kbeg * NMOD + col;
    for (int k0 = 0; k0 < nk; k0 += 16) {
        float4 w[16];
#pragma unroll
        for (int u = 0; u < 16; ++u) { w[u] = make_float4(0.f, 0.f, 0.f, 0.f); if (k0 + u < nk) { const f4 t_ = __builtin_nontemporal_load((const f4*)(wp + (size_t)(k0 + u) * NMOD)); w[u] = make_float4(t_[0], t_[1], t_[2], t_[3]); } }
#pragma unroll
        for (int u = 0; u < 16; ++u) { const int k = (k0 + u < nk) ? k0 + u : 0;
            const f4 s0 = *(const LAS f4*)(sc + k * 8), s1 = *(const LAS f4*)(sc + k * 8 + 4);
            const float sv[8] = {s0[0], s0[1], s0[2], s0[3], s1[0], s1[1], s1[2], s1[3]};
#pragma unroll
            for (int b = 0; b < NB; ++b) { acc[b][0] += sv[b] * w[u].x; acc[b][1] += sv[b] * w[u].y; acc[b][2] += sv[b] * w[u].z; acc[b][3] += sv[b] * w[u].w; } }
    }
#pragma unroll
    for (int b = 0; b < NB; ++b) *(float4*)(part + ((size_t)ks * NB + b) * NMOD + col) = make_float4(acc[b][0], acc[b][1], acc[b][2], acc[b][3]);
    __syncthreads();
}
__device__ __forceinline__ float mod_reduce(const float* part, const float* b_ada, int b, int j) {
    float s = b_ada[j];
#pragma unroll
    for (int ks = 0; ks < MOD_KS; ++ks) s += part[((size_t)ks * NB + b) * NMOD + j];
    return s;
}
__device__ __forceinline__ void p0_transpose(const float* W, int K, int N, int Npad, bf16_t* Wt, LAS unsigned char* lds, int blk, int nblk, unsigned* amax = nullptr) {
    const int tid = threadIdx.x; LAS float* tile = (LAS float*)lds;
    const int tk = K / 64, tn = Npad / 64, ntile = tk * tn;
    float4 v[8][2];
#define TR_LOAD(X, tt0) do { _Pragma("unroll") for (int q = 0; q < 8; ++q) { const int t = (tt0) + q; const int k0 = (t % tk) * 64, n0 = (t / tk) * 64; \
        _Pragma("unroll") for (int p = 0; p < 2; ++p) { const int r = (tid >> 4) + p * 32, c4 = (tid & 15) * 4; X[q][p] = make_float4(0.f, 0.f, 0.f, 0.f); \
            if (t < ntile && n0 + c4 < N) { const f4 t_ = __builtin_nontemporal_load((const f4*)(W + (size_t)(k0 + r) * N + n0 + c4)); X[q][p] = make_float4(t_[0], t_[1], t_[2], t_[3]); } } } } while (0)
    int t0 = blk * 8;
    if (t0 < ntile) TR_LOAD(v, t0);
    for (; t0 < ntile; t0 += nblk * 8) {
        float4 nv[8][2];
        TR_LOAD(nv, t0 + nblk * 8);
#pragma unroll
        for (int q = 0; q < 8; ++q)
#pragma unroll
            for (int p = 0; p < 2; ++p) { const int r = (tid >> 4) + p * 32, c4 = (tid & 15) * 4; LAS float* tp = tile + q * 4160 + r * 65 + c4;
                tp[0] = v[q][p].x; tp[1] = v[q][p].y; tp[2] = v[q][p].z; tp[3] = v[q][p].w; }
        __syncthreads();
#pragma unroll
        for (int q = 0; q < 8; ++q) { const int t = t0 + q; const int k0 = (t % tk) * 64, n0 = (t / tk) * 64; const LAS float* tq = tile + q * 4160;
            if (t < ntile) { const int n = tid >> 3, ks = (tid & 7) * 8; uint4 o;
                o.x = pk_bf16(tq[(ks + 0) * 65 + n], tq[(ks + 1) * 65 + n]); o.y = pk_bf16(tq[(ks + 2) * 65 + n], tq[(ks + 3) * 65 + n]);
                o.z = pk_bf16(tq[(ks + 4) * 65 + n], tq[(ks + 5) * 65 + n]); o.w = pk_bf16(tq[(ks + 6) * 65 + n], tq[(ks + 7) * 65 + n]);
                *(uint4*)(Wt + (size_t)(n0 + n) * K + k0 + ks) = o;
                if (amax) { float m = 0.f;
#pragma unroll
                    for (int e = 0; e < 8; ++e) m = fmaxf(m, fabsf(tq[(ks + e) * 65 + n]));
                    m = fmaxf(m, __shfl_xor(m, 1)); m = fmaxf(m, __shfl_xor(m, 2)); m = fmaxf(m, __shfl_xor(m, 4));
                    if ((tid & 7) == 0) atomicMax(amax + n0 + n, __float_as_uint(m)); } } }
        __syncthreads();
#pragma unroll
        for (int q = 0; q < 8; ++q)
#pragma unroll
            for (int p = 0; p < 2; ++p) v[q][p] = nv[q][p];
    }
#undef TR_LOAD
}
template <bool FROM_PART>
__device__ __forceinline__ void p_norm_mod(const float* x, const float* g, const float* mod, const float* part, const float* b_ada, float* mod_out, int shift_off, int scale_off, bf16_t* H, LAS unsigned char* lds, int blk, unsigned char* Hq = nullptr, float* hqs = nullptr) {
    const int tid = threadIdx.x, lane = tid & 63, wv = tid >> 6; const int b = (blk * 64) / NT;
    LAS float* av = (LAS float*)lds; LAS float* sv = av + DM;
    if (FROM_PART) {
        for (int i = tid; i < DM; i += NTHR) { av[i] = g[i] * (1.0f + mod_reduce(part, b_ada, b, scale_off + i)); sv[i] = mod_reduce(part, b_ada, b, shift_off + i); }
        for (int o = blk * 768 + tid; o < blk * 768 + 768; o += NTHR) mod_out[o] = mod_reduce(part, b_ada, o / NMOD, o % NMOD);
    } else {
        for (int i = tid; i < DM; i += NTHR) { av[i] = g[i] * (1.0f + mod[(size_t)b * NMOD + scale_off + i]); sv[i] = mod[(size_t)b * NMOD + shift_off + i]; }
    }
    __syncthreads();
    float4 v[16];
    { const float* xr = x + (size_t)(blk * 64 + wv) * DM;
#pragma unroll
      for (int i = 0; i < 16; ++i) v[i] = *(const float4*)(xr + i * 256 + lane * 4); }
#pragma unroll 1
    for (int tt = wv; tt < 64; tt += NWAVES) {
        const int tok = blk * 64 + tt; float4 nv[16];
        if (tt + NWAVES < 64) { const float* xn = x + (size_t)(tok + NWAVES) * DM;
#pragma unroll
            for (int i = 0; i < 16; ++i) nv[i] = *(const float4*)(xn + i * 256 + lane * 4); }
        float ss = 0.f;
#pragma unroll
        for (int i = 0; i < 16; ++i) ss += v[i].x * v[i].x + v[i].y * v[i].y + v[i].z * v[i].z + v[i].w * v[i].w;
        ss = wave_sum(ss); const float rstd = rsqrtf(ss * (1.0f / DM) + 1e-6f);
        float hm = 0.f;
#pragma unroll
        for (int i = 0; i < 16; ++i) { const int col = i * 256 + lane * 4; const f4 a = *(const LAS f4*)(av + col), s = *(const LAS f4*)(sv + col);
            v[i].x = v[i].x * rstd * a.x + s.x; v[i].y = v[i].y * rstd * a.y + s.y; v[i].z = v[i].z * rstd * a.z + s.z; v[i].w = v[i].w * rstd * a.w + s.w;
            hm = fmaxf(hm, fmaxf(fmaxf(fabsf(v[i].x), fabsf(v[i].y)), fmaxf(fabsf(v[i].z), fabsf(v[i].w))));
            uint2 o; o.x = pk_bf16(v[i].x, v[i].y); o.y = pk_bf16(v[i].z, v[i].w);
            *(uint2*)(H + (size_t)tok * DM + col) = o; }
        if (Hq) { hm = wave_max(hm); const float qi = hm > 0.f ? 119.0f / hm : 0.f;
            if (lane == 0) hqs[tok] = hm * (1.0f / 119.0f);
#pragma unroll
            for (int i = 0; i < 16; ++i) { const int col = i * 256 + lane * 4;
                const int q4[4] = {__float2int_rn(v[i].x * qi), __float2int_rn(v[i].y * qi), __float2int_rn(v[i].z * qi), __float2int_rn(v[i].w * qi)};
                unsigned hh = 0u, hl = 0u;
#pragma unroll
                for (int e = 0; e < 4; ++e) { const int lo = ((q4[e] + 8) & 15) - 8, hi = (q4[e] - lo) >> 4; hl |= ((unsigned)lo & 15u) << (4 * e); hh |= ((unsigned)hi & 15u) << (4 * e); }
                const unsigned oddl = lane & 1;
                const unsigned pv = (unsigned)__shfl_xor((int)(oddl ? hh : hl), 1);
                *(unsigned*)(Hq + (size_t)tok * DM + col) = oddl ? (pv | (hl << 16)) : (hh | (pv << 16)); } }
        if (tt + NWAVES < 64) {
#pragma unroll
            for (int i = 0; i < 16; ++i) v[i] = nv[i]; }
    }
    __syncthreads();
}
}
namespace {
typedef __bf16 bf16x2_t __attribute__((ext_vector_type(2)));
typedef short bf16x8 __attribute__((ext_vector_type(8)));
typedef float f32x16 __attribute__((ext_vector_type(16)));
typedef unsigned u4 __attribute__((ext_vector_type(4)));
__device__ __forceinline__ float dot2c(unsigned a, unsigned b, float acc) { return __builtin_amdgcn_fdot2_f32_bf16(__builtin_bit_cast(bf16x2_t, a), __builtin_bit_cast(bf16x2_t, b), acc, false); }

constexpr size_t PEER_SLAB = (size_t)16384 * 128;
constexpr size_t WS_UB = WS_END_A;
constexpr size_t WS_VB = WS_UB + 32 * PEER_SLAB;
constexpr size_t WS_KEYSB = WS_VB + 32 * PEER_SLAB;
constexpr size_t WS_EIDX = WS_KEYSB + (size_t)16 * 128 * 128 * 2;
constexpr size_t WS_GW = WS_EIDX + (size_t)NTOK * 128 * 4;
constexpr size_t WS_PW = WS_GW + (size_t)NTOK * 128 * 4;
constexpr size_t WS_END_B = WS_PW + (size_t)NTOK * 128 * 4;

__device__ __forceinline__ void p0_peer_cvt(const float* src, bf16_t* dst, int blk, int nblk) {
    const int tid = threadIdx.x, w = tid >> 6, lane = tid & 63;
    for (int eb = blk; eb < 256; eb += nblk) {
        const int e = eb * 64 + w * 8 + (lane >> 3);
        const float* r = src + (size_t)e * DM + (lane & 7) * 8; bf16_t* d = dst + (size_t)e * 64 + (lane & 7) * 8;
#pragma unroll 1
        for (int c0 = 0; c0 < 64; c0 += 8) {
            float4 a[8], b[8];
#pragma unroll
            for (int u = 0; u < 8; ++u) { a[u] = *(const float4*)(r + (c0 + u) * 64); b[u] = *(const float4*)(r + (c0 + u) * 64 + 4); }
#pragma unroll
            for (int u = 0; u < 8; ++u) { uint4 o; o.x = pk_bf16(a[u].x, a[u].y); o.y = pk_bf16(a[u].z, a[u].w); o.z = pk_bf16(b[u].x, b[u].y); o.w = pk_bf16(b[u].z, b[u].w);
                *(uint4*)(d + (size_t)(c0 + u) * 16384 * 64) = o; }
        }
    }
}
__device__ __forceinline__ void p0_cvt_flat(const float* src, bf16_t* dst, int n, int blk, int nblk) {
    for (int i = (blk * NTHR + threadIdx.x) * 4; i < n; i += nblk * NTHR * 4) { const float4 v = *(const float4*)(src + i); uint2 o; o.x = pk_bf16(v.x, v.y); o.y = pk_bf16(v.z, v.w); *(uint2*)(dst + i) = o; }
}

__device__ __forceinline__ int f2key(float f) { const int b = __float_as_int(f); return b ^ ((b >> 31) & 0x7fffffff); }
__device__ __forceinline__ float key2f(int k) { return __int_as_float(k ^ ((k >> 31) & 0x7fffffff)); }
#define CE_DESC(a, b) do { const int _mx = max(a, b), _mn = min(a, b); a = _mx; b = _mn; } while (0)
__device__ __forceinline__ void sort16_desc(int (&v)[16]) {
#pragma unroll
    for (int lk = 1; lk <= 4; ++lk)
#pragma unroll
        for (int lj = lk - 1; lj >= 0; --lj)
#pragma unroll
            for (int i = 0; i < 16; ++i) { const int k = 1 << lk, j = 1 << lj, l = i ^ j;
                if (l > i) { if ((i & k) == 0 || k == 16) { CE_DESC(v[i], v[l]); } else { CE_DESC(v[l], v[i]); } } }
}
__device__ __forceinline__ void merge16_desc(int (&v)[16]) {
#pragma unroll
    for (int lj = 3; lj >= 0; --lj)
#pragma unroll
        for (int i = 0; i < 16; ++i) { const int j = 1 << lj, l = i ^ j; if (l > i) CE_DESC(v[i], v[l]); }
}
__device__ __forceinline__ void top16_of_64(const int (&v)[64], int (&o)[16]) {
    int g[4][16];
#pragma unroll
    for (int q = 0; q < 4; ++q) {
#pragma unroll
        for (int i = 0; i < 16; ++i) g[q][i] = v[q * 16 + i];
        sort16_desc(g[q]); }
#pragma unroll
    for (int i = 0; i < 16; ++i) { g[0][i] = max(g[0][i], g[1][15 - i]); g[2][i] = max(g[2][i], g[3][15 - i]); }
    merge16_desc(g[0]); merge16_desc(g[2]);
#pragma unroll
    for (int i = 0; i < 16; ++i) o[i] = max(g[0][i], g[2][15 - i]);
    merge16_desc(o);
}
__device__ __forceinline__ void p8_topk(const bf16_t* QP, const bf16_t* KEYS, unsigned* eidx, float* gw, LAS unsigned char* lds, int blk, int nblk) {
    const int tid = threadIdx.x, h = __builtin_amdgcn_readfirstlane(tid >> 6), lane = tid & 63, r32 = lane & 31, hi = lane >> 5;
    LAS int* slot = (LAS int*)lds + h * 32 * 64 + lane;
    LAS unsigned char* pct = lds + 65536;
    if (tid == 0) { int pc = 0; for (int i = 0; i < 16; ++i) for (int j = 0; j < 16; ++j) if ((i + 1) * (j + 1) <= 16) pct[pc++] = (unsigned char)(i * 16 + j); }
    __syncthreads();
    for (int tb = 2 * blk; tb < 2 * blk + 2 && tb < NTOK / 32; ++tb) {
        const int tok = tb * 32 + r32;
        int vs[2][16];
#pragma unroll
        for (int c = 0; c < 2; ++c) {
            const int list = h * 2 + c;
            bf16x8 qf[8];
#pragma unroll
            for (int d0 = 0; d0 < 8; ++d0) qf[d0] = *(const bf16x8*)(QP + (size_t)tok * 2048 + list * 128 + d0 * 16 + hi * 8);
            int v[64];
#pragma unroll
            for (int kt = 0; kt < 4; ++kt) {
                f32x16 s = {};
                const bf16_t* kp = KEYS + ((size_t)(list * 4 + kt) * 8) * 512 + lane * 8; asm volatile("" : "+v"(kp));
#pragma unroll
                for (int d0 = 0; d0 < 8; ++d0) { const bf16x8 kf = *(const bf16x8*)(kp + d0 * 512);
                    s = __builtin_amdgcn_mfma_f32_32x32x16_bf16(kf, qf[d0], s, 0, 0, 0); }
#pragma unroll
                for (int r = 0; r < 16; ++r) v[kt * 16 + r] = (f2key(s[r]) & ~127) | (hi << 6) | (kt * 16 + r);
                asm volatile("" ::: "memory"); __builtin_amdgcn_sched_barrier(0);
            }
            int t[16]; top16_of_64(v, t);
#pragma unroll
            for (int i = 0; i < 16; ++i) { const int p = __shfl_xor(t[15 - i], 32); vs[c][i] = max(t[i], p); }
            merge16_desc(vs[c]);
#pragma unroll
            for (int i = 0; i < 16; ++i) slot[(c * 16 + i) * 64] = vs[c][i];
            asm volatile("" ::: "memory"); __builtin_amdgcn_sched_barrier(0);
        }
        int cv[64]; int pc = 0;
#pragma unroll
        for (int i = 0; i < 16; ++i)
#pragma unroll
            for (int j = 0; j < 16; ++j) if ((i + 1) * (j + 1) <= 16) { cv[pc] = (f2key(key2f(vs[0][i]) + key2f(vs[1][j])) & ~63) | pc; ++pc; }
#pragma unroll
        for (int q = 50; q < 64; ++q) cv[q] = (int)0x80000000;
        int w[16]; top16_of_64(cv, w);
        const float m = key2f(w[0]); float p[16], den = 0.f; unsigned ee[16];
#pragma unroll
        for (int k = 0; k < 16; ++k) { p[k] = __expf(key2f(w[k]) - m); den += p[k];
            const int ij = pct[w[k] & 63]; const int c1 = slot[(ij >> 4) * 64] & 127, c2 = slot[(16 + (ij & 15)) * 64] & 127;
            const int k1 = ((c1 >> 4) & 3) * 32 + (c1 & 3) + 8 * ((c1 >> 2) & 3) + 4 * (c1 >> 6), k2 = ((c2 >> 4) & 3) * 32 + (c2 & 3) + 8 * ((c2 >> 2) & 3) + 4 * (c2 >> 6);
            ee[k] = (unsigned)(k1 * 128 + k2); }
        const float rden = 1.0f / den; const unsigned hm = (unsigned)(-hi);
        u4 e0, e1; f4 g0, g1;
#pragma unroll
        for (int k = 0; k < 4; ++k) {
            e0[k] = ee[k] ^ ((ee[k] ^ ee[8 + k]) & hm); e1[k] = ee[4 + k] ^ ((ee[4 + k] ^ ee[12 + k]) & hm);
            const unsigned pa = __float_as_uint(p[k]), pb = __float_as_uint(p[8 + k]), pc2 = __float_as_uint(p[4 + k]), pd = __float_as_uint(p[12 + k]);
            g0[k] = __uint_as_float(pa ^ ((pa ^ pb) & hm)) * rden; g1[k] = __uint_as_float(pc2 ^ ((pc2 ^ pd) & hm)) * rden; }
        const size_t o = (size_t)tok * 128 + h * 16 + hi * 8;
        *(u4*)(eidx + o) = e0; *(u4*)(eidx + o + 4) = e1; *(f4*)(gw + o) = g0; *(f4*)(gw + o + 4) = g1;
    }
    __syncthreads();
}

__device__ __forceinline__ void p9_peer_u(const bf16_t* H, const bf16_t* Ub, const unsigned* eidx, const float* gw, float* pw, LAS unsigned char* lds, int blk) {
    const int tid = threadIdx.x, wv = tid >> 6, lane = tid & 63, tl = lane >> 3, j = lane & 7;
    LAS unsigned* eo = (LAS unsigned*)lds;
    const int base = blk * 64;
    for (int i = tid; i < 64 * 128; i += NTHR) eo[i] = eidx[(size_t)base * 128 + i] * 128u;
    __syncthreads();
    const int tok = base + wv * 8 + tl;
    const LAS unsigned* myeo = eo + (wv * 8 + tl) * 128;
    float acc[128];
#pragma unroll
    for (int k = 0; k < 128; ++k) acc[k] = 0.f;
    const bf16_t* hrow = H + (size_t)tok * DM + j * 8;
    for (int c = 0; c < 64; ++c) {
        const uint4 hv = *(const uint4*)(hrow + c * 64);
        const unsigned char* slab = (const unsigned char*)Ub + (size_t)c * PEER_SLAB + j * 16;
        uint4 ub[2][8];
#define P9_LOAD(g, B) do { const u4 oa = *(const LAS u4*)(myeo + (g) * 8), ob = *(const LAS u4*)(myeo + (g) * 8 + 4); \
            _Pragma("unroll") for (int q = 0; q < 4; ++q) { ub[B][q] = *(const uint4*)(slab + oa[q]); ub[B][4 + q] = *(const uint4*)(slab + ob[q]); } \
            asm volatile("" ::: "memory"); __builtin_amdgcn_sched_barrier(0); } while (0)
#define P9_DOT(g, B) do { _Pragma("unroll") for (int q = 0; q < 8; ++q) { float a = acc[(g) * 8 + q]; const uint4 u = ub[B][q]; \
            a = dot2c(u.x, hv.x, a); a = dot2c(u.y, hv.y, a); a = dot2c(u.z, hv.z, a); a = dot2c(u.w, hv.w, a); acc[(g) * 8 + q] = a; } } while (0)
        P9_LOAD(0, 0);
#pragma unroll
        for (int g = 0; g < 16; g += 2) {
            P9_LOAD(g + 1, 1); P9_DOT(g, 0);
            if (g + 2 < 16) P9_LOAD(g + 2, 0);
            P9_DOT(g + 1, 1);
        }
#undef P9_LOAD
#undef P9_DOT
    }
#pragma unroll
    for (int i = 0; i < 64; ++i) { const bool up = (j & 4) != 0; const float snd = up ? acc[i] : acc[i + 64], kp = up ? acc[i + 64] : acc[i]; acc[i] = kp + __shfl_xor(snd, 4); }
#pragma unroll
    for (int i = 0; i < 32; ++i) { const bool up = (j & 2) != 0; const float snd = up ? acc[i] : acc[i + 32], kp = up ? acc[i + 32] : acc[i]; acc[i] = kp + __shfl_xor(snd, 2); }
#pragma unroll
    for (int i = 0; i < 16; ++i) { const bool up = (j & 1) != 0; const float snd = up ? acc[i] : acc[i + 16], kp = up ? acc[i + 16] : acc[i]; acc[i] = kp + __shfl_xor(snd, 1); }
    const int k0 = ((j >> 2) & 1) * 64 + ((j >> 1) & 1) * 32 + (j & 1) * 16;
    const float* gp = gw + (size_t)tok * 128 + k0; float* wp = pw + (size_t)tok * 128 + k0;
#pragma unroll
    for (int i = 0; i < 16; i += 4) { f4 g = *(const f4*)(gp + i); g[0] *= gelu_exact(acc[i]); g[1] *= gelu_exact(acc[i + 1]); g[2] *= gelu_exact(acc[i + 2]); g[3] *= gelu_exact(acc[i + 3]); *(f4*)(wp + i) = g; }
    __syncthreads();
}

__device__ __forceinline__ void p10_peer_v(const bf16_t* Vb, const unsigned* eidx, const float* gw, const float* gate2, const float* x1, float* out, LAS unsigned char* lds, int blk) {
    const int tid = threadIdx.x, wv = tid >> 6, lane = tid & 63, tl = lane >> 3, j = lane & 7;
    LAS unsigned* eo = (LAS unsigned*)lds; LAS unsigned* wl = eo + 64 * 128;
    const int base = blk * 64;
    for (int i = tid; i < 64 * 128; i += NTHR) { eo[i] = eidx[(size_t)base * 128 + i] * 128u; wl[i] = (unsigned)f2bf(gw[(size_t)base * 128 + i]); }
    __syncthreads();
    const int tok = base + wv * 8 + tl, b = tok / NT;
    const LAS unsigned* myeo = eo + (wv * 8 + tl) * 128; const LAS unsigned* mywl = wl + (wv * 8 + tl) * 128;
    for (int c = 0; c < 64; ++c) {
        const unsigned char* slab = (const unsigned char*)Vb + (size_t)c * PEER_SLAB + j * 16;
        float acc[8];
#pragma unroll
        for (int i = 0; i < 8; ++i) acc[i] = 0.f;
#pragma unroll 8
        for (int k4 = 0; k4 < 32; ++k4) {
            const u4 o4 = *(const LAS u4*)(myeo + k4 * 4); const u4 w4 = *(const LAS u4*)(mywl + k4 * 4);
#pragma unroll
            for (int q = 0; q < 4; ++q) { const uint4 u = *(const uint4*)(slab + o4[q]); const unsigned wlo = w4[q], whi = wlo << 16;
                acc[0] = dot2c(u.x, wlo, acc[0]); acc[1] = dot2c(u.x, whi, acc[1]); acc[2] = dot2c(u.y, wlo, acc[2]); acc[3] = dot2c(u.y, whi, acc[3]);
                acc[4] = dot2c(u.z, wlo, acc[4]); acc[5] = dot2c(u.z, whi, acc[5]); acc[6] = dot2c(u.w, wlo, acc[6]); acc[7] = dot2c(u.w, whi, acc[7]); }
        }
        const int col = c * 64 + j * 8; float* op = out + (size_t)tok * DM + col; const float* xp = x1 + (size_t)tok * DM + col; const float* gp = gate2 + (size_t)b * NMOD + col;
        f4 x0 = *(const f4*)xp, x1 = *(const f4*)(xp + 4); const f4 g0 = *(const f4*)gp, g1 = *(const f4*)(gp + 4);
        x0[0] += g0[0] * acc[0]; x0[1] += g0[1] * acc[1]; x0[2] += g0[2] * acc[2]; x0[3] += g0[3] * acc[3];
        x1[0] += g1[0] * acc[4]; x1[1] += g1[1] * acc[5]; x1[2] += g1[2] * acc[6]; x1[3] += g1[3] * acc[7];
        *(f4*)op = x0; *(f4*)(op + 4) = x1;
    }
    __syncthreads();
}
}
namespace {
typedef unsigned u2 __attribute__((ext_vector_type(2)));
constexpr size_t WS_ROPE = WS_END_B;
constexpr size_t WS_WPT = WS_ROPE + (size_t)2 * NT * 64 * 4;
constexpr size_t WS_W1T = WS_WPT + (size_t)4 * 256 * 256 * 2;
constexpr size_t WS_W2T = WS_W1T + (size_t)2 * 256 * 4096 * 2;
constexpr size_t WS_PEB = WS_W2T + (size_t)2 * 128 * 256 * 2;
constexpr size_t WS_KSEL = WS_PEB + 4096;
constexpr size_t WS_KWIN = WS_KSEL + (size_t)NTOK * 512 * 2;
constexpr size_t WS_CMPK = WS_KWIN + (size_t)NTOK * 512 * 2;
constexpr size_t WS_CMPV = WS_CMPK + (size_t)NB * 4 * 128 * 128 * 2;
constexpr size_t WS_OC = WS_CMPV + (size_t)NB * 4 * 128 * 128 * 2;
constexpr size_t WS_SELM = WS_OC + (size_t)NTOK * 3072 * 2;
constexpr size_t WS_PART = WS_SELM + (size_t)NTOK * 4 * 4;
constexpr size_t WS_END_C = WS_PART + (size_t)MOD_KS * NB * NMOD * 4;

__device__ __forceinline__ float sigmoidf_(float v) { return 1.0f / (1.0f + __expf(-v)); }
__device__ __forceinline__ void p0_rope(float* rope, int blk, int nblk) {
    for (int i = blk * NTHR + threadIdx.x; i < NT * 64; i += nblk * NTHR) { const int t = i >> 6, k = i & 63;
        const float inv = powf(10000.f, -(float)k / 64.f); float sn, cs; sincosf((float)t * inv, &sn, &cs); rope[i] = cs; rope[NT * 64 + i] = sn; }
}
__device__ __forceinline__ void p0_peb(const float* pe, const float* w1, float* peb, LAS unsigned char* lds, int blk) {
    if (blk >= 256) return;
    const int tid = threadIdx.x, kv = blk >> 7, h = (blk & 127) * 2; float a0 = 0.f, a1 = 0.f;
#pragma unroll
    for (int i = 0; i < 8; ++i) { const int k = tid + i * NTHR; const float p = pe[kv * 4096 + k]; const float2 w = *(const float2*)(w1 + ((size_t)kv * 4096 + k) * 256 + h); a0 += p * w.x; a1 += p * w.y; }
    a0 = wave_sum(a0); a1 = wave_sum(a1);
    LAS float* red = (LAS float*)lds;
    if ((tid & 63) == 0) { red[(tid >> 6) * 2] = a0; red[(tid >> 6) * 2 + 1] = a1; }
    __syncthreads();
    if (tid < 2) { float s = 0.f; for (int w = 0; w < NWAVES; ++w) s += red[w * 2 + tid]; peb[kv * 256 + h + tid] = s; }
    __syncthreads();
}

__device__ __forceinline__ void p0_frag(const float* src, size_t rstride, size_t cstride, int ntiles, int nsteps, bf16_t* dst, int blk, int nblk) {
    const int total = ntiles * nsteps * 64;
    for (int p = blk * NTHR + threadIdx.x; p < total; p += nblk * NTHR) {
        const int lane = p & 63, st = (p >> 6) % nsteps, tile = (p >> 6) / nsteps; const int row = tile * 32 + (lane & 31), col = st * 16 + (lane >> 5) * 8;
        const float* s = src + (size_t)row * rstride + (size_t)col * cstride; float v[8];
#pragma unroll
        for (int e = 0; e < 8; ++e) v[e] = s[(size_t)e * cstride];
        uint4 o; o.x = pk_bf16(v[0], v[1]); o.y = pk_bf16(v[2], v[3]); o.z = pk_bf16(v[4], v[5]); o.w = pk_bf16(v[6], v[7]);
        *(uint4*)(dst + (size_t)p * 8) = o;
    }
}
__device__ __forceinline__ void p3_knorm(const bf16_t* PROJ, const float* k_norm_g, const float* rope, bf16_t* KSEL, bf16_t* KWIN, int blk) {
    const int tid = threadIdx.x, l16 = tid & 15, vg = tid >> 4;
#pragma unroll 4
    for (int it = 0; it < 16; ++it) {
        const int task = it * 32 + vg, tok = blk * 64 + (task >> 3), s = task & 7, br = 1 + (s >> 2), g = s & 3, b = tok / NT, t = tok % NT;
        const uint4 u = *(const uint4*)(PROJ + (size_t)tok * PLD + KVOFF + ((br * 2 + 0) * 4 + g) * 128 + l16 * 8);
        const unsigned uu[4] = {u.x, u.y, u.z, u.w}; float xv[8]; float ss = 0.f;
#pragma unroll
        for (int e = 0; e < 4; ++e) { xv[2 * e] = __uint_as_float(uu[e] << 16); xv[2 * e + 1] = __uint_as_float(uu[e] & 0xffff0000u); ss += xv[2 * e] * xv[2 * e] + xv[2 * e + 1] * xv[2 * e + 1]; }
        ss += __shfl_xor(ss, 1); ss += __shfl_xor(ss, 2); ss += __shfl_xor(ss, 4); ss += __shfl_xor(ss, 8);
        const float rstd = rsqrtf(ss * (1.0f / 128.f) + 1e-6f);
        const float* gp = k_norm_g + br * 128 + l16 * 8; const f4 g0 = *(const f4*)gp, g1 = *(const f4*)(gp + 4);
        const float* cp = rope + t * 64 + (l16 & 7) * 8; const f4 c0 = *(const f4*)cp, c1 = *(const f4*)(cp + 4), s0 = *(const f4*)(cp + NT * 64), s1 = *(const f4*)(cp + NT * 64 + 4);
        float y[8], o[8];
#pragma unroll
        for (int e = 0; e < 8; ++e) y[e] = xv[e] * rstd * (e < 4 ? g0[e & 3] : g1[e & 3]);
#pragma unroll
        for (int e = 0; e < 8; ++e) { const float other = __shfl_xor(y[e], 8); const float cs = e < 4 ? c0[e & 3] : c1[e & 3], sn = e < 4 ? s0[e & 3] : s1[e & 3];
            o[e] = (l16 < 8) ? (y[e] * cs - other * sn) : (y[e] * cs + other * sn); }
        uint4 w; w.x = pk_bf16(o[0], o[1]); w.y = pk_bf16(o[2], o[3]); w.z = pk_bf16(o[4], o[5]); w.w = pk_bf16(o[6], o[7]);
        *(uint4*)((br == 1 ? KSEL : KWIN) + (((size_t)b * 4 + g) * NT + t) * 128 + l16 * 8) = w;
    }
}
__device__ __forceinline__ void p3_compress(const bf16_t* PROJ, const bf16_t* W1F, const bf16_t* W2T, const float* peb, const float* k_norm_g, bf16_t* CMPK, bf16_t* CMPV, LAS unsigned char* lds, int blk, int nblk) {
    const int tid = threadIdx.x, wv = __builtin_amdgcn_readfirstlane(tid >> 6), lane = tid & 63, r32 = lane & 31, hi = lane >> 5;
    LAS bf16_t* hidL = (LAS bf16_t*)lds;
    LAS float* ssL = (LAS float*)(lds + 32768);
    for (int item = blk; item < 256; item += nblk) {
        const int nt = item & 3, g = (item >> 2) & 3, b = (item >> 4) & 7, kv = item >> 7;
        int n = nt * 32 + r32;
        const int sr_ = tid >> 4, sc_ = (tid & 15) * 8; const int nrow = nt * 32 + sr_, ncl = nrow < NCMP ? nrow : NCMP - 1;
        const bf16_t* arow = PROJ + (size_t)(b * NT + 16 * ncl) * PLD + KVOFF + ((0 * 2 + kv) * 4 + g) * 128 + sc_;
        const bf16_t* wfr = W1F + ((size_t)(kv * 8 + wv) * 32 * 8) * 512 + lane * 8;
        LAS bf16_t* afL = (LAS bf16_t*)(lds + 49152);
        f32x16 acc = {};
        bf16x8 wfb[2][8]; uint4 astg;
#define CMP_LOAD(B, l) do { const bf16_t* wp = wfr + (size_t)(l) * 8 * 512; \
            _Pragma("unroll") for (int d0 = 0; d0 < 8; ++d0) wfb[B][d0] = *(const bf16x8*)(wp + d0 * 512); \
            astg = *(const uint4*)(arow + (size_t)(l) * PLD); asm volatile("" ::: "memory"); __builtin_amdgcn_sched_barrier(0); } while (0)
#define CMP_STAGE(B) do { u4 sv_ = {astg.x, astg.y, astg.z, astg.w}; *(LAS u4*)(afL + (B) * 4352 + sr_ * 136 + sc_) = sv_; } while (0)
#define CMP_MMA(B) do { _Pragma("unroll") for (int d0 = 0; d0 < 8; ++d0) { const bf16x8 af = *(const LAS bf16x8*)(afL + (B) * 4352 + r32 * 136 + d0 * 16 + hi * 8); \
            acc = __builtin_amdgcn_mfma_f32_32x32x16_bf16(wfb[B][d0], af, acc, 0, 0, 0); } } while (0)
        CMP_LOAD(0, 0); CMP_STAGE(0); __syncthreads();
#pragma unroll 1
        for (int l = 0; l < 32; l += 2) {
            CMP_LOAD(1, l + 1); CMP_MMA(0); CMP_STAGE(1); __syncthreads();
            if (l + 2 < 32) CMP_LOAD(0, l + 2);
            CMP_MMA(1); if (l + 2 < 32) CMP_STAGE(0); __syncthreads();
        }
#undef CMP_LOAD
#undef CMP_STAGE
#undef CMP_MMA
#pragma unroll
        for (int a = 0; a < 4; ++a) { const int h0 = wv * 32 + 8 * a + 4 * hi; const f4 pb = *(const f4*)(peb + kv * 256 + h0);
            uint2 o; o.x = pk_bf16(gelu_exact(acc[4 * a] + pb[0]), gelu_exact(acc[4 * a + 1] + pb[1])); o.y = pk_bf16(gelu_exact(acc[4 * a + 2] + pb[2]), gelu_exact(acc[4 * a + 3] + pb[3]));
            u2 ov = {o.x, o.y}; *(LAS u2*)(hidL + r32 * 264 + h0) = ov; }
        __syncthreads();
        f32x16 o2 = {};
        if (wv < 4) {
            const bf16_t* w2row = W2T + ((size_t)kv * 128 + wv * 32 + r32) * 256 + hi * 8;
#pragma unroll
            for (int k0 = 0; k0 < 16; ++k0) { const bf16x8 wf = *(const bf16x8*)(w2row + k0 * 16); const bf16x8 hf = *(const LAS bf16x8*)(hidL + r32 * 264 + k0 * 16 + hi * 8);
                o2 = __builtin_amdgcn_mfma_f32_32x32x16_bf16(wf, hf, o2, 0, 0, 0); }
            if (kv == 0) { float ss = 0.f;
#pragma unroll
                for (int r = 0; r < 16; ++r) ss += o2[r] * o2[r];
                ss += __shfl_xor(ss, 32); if (hi == 0) ssL[wv * 32 + r32] = ss; }
        }
        __syncthreads();
        if (wv < 4) {
            float rstd = 1.f;
            if (kv == 0) rstd = rsqrtf((ssL[r32] + ssL[32 + r32] + ssL[64 + r32] + ssL[96 + r32]) * (1.0f / 128.f) + 1e-6f);
            bf16_t* dst = (kv == 0 ? CMPK : CMPV) + (((size_t)b * 4 + g) * 128 + n) * 128;
#pragma unroll
            for (int a = 0; a < 4; ++a) { const int d0 = wv * 32 + 8 * a + 4 * hi; f4 gg = {1.f, 1.f, 1.f, 1.f}; if (kv == 0) gg = *(const f4*)(k_norm_g + d0);
                uint2 o; o.x = pk_bf16(o2[4 * a] * rstd * gg[0], o2[4 * a + 1] * rstd * gg[1]); o.y = pk_bf16(o2[4 * a + 2] * rstd * gg[2], o2[4 * a + 3] * rstd * gg[3]);
                if (n >= NCMP) { o.x = 0u; o.y = 0u; }
                *(uint2*)(dst + d0) = o; }
        }
        __syncthreads();
    }
}
__device__ __forceinline__ void p3_pool(const bf16_t* PROJ, const bf16_t* WPF, const float* pool_scale, bf16_t* MIX, LAS unsigned char* lds, int blk, int nblk) {
    const int tid = threadIdx.x, wv = __builtin_amdgcn_readfirstlane(tid >> 6), lane = tid & 63, r32 = lane & 31, hi = lane >> 5;
    LAS bf16_t* dL = (LAS bf16_t*)(lds + 40960);
    for (int it = 0; it < 4; ++it) {
        const int item = blk * 4 + it; if (item >= 1024) break;
        const int gi = item & 3, tt = item >> 2, tok0 = tt * 64, w = 2 << gi;
        { const int tg = tid >> 5, c0 = (tid & 31) * 8; const int tokA = tok0 + tg * 4, tA = tokA % NT;
          float rv[19][8];
#pragma unroll
          for (int q = 0; q < 19; ++q) { const int rel = q - 15;
              uint4 u = make_uint4(0u, 0u, 0u, 0u);
              if (rel >= 1 - w && tA + rel >= 0) u = *(const uint4*)(PROJ + (size_t)(tokA + rel) * PLD + gi * 256 + c0);
              const unsigned uu[4] = {u.x, u.y, u.z, u.w};
#pragma unroll
              for (int e = 0; e < 4; ++e) { rv[q][2 * e] = __uint_as_float(uu[e] << 16); rv[q][2 * e + 1] = __uint_as_float(uu[e] & 0xffff0000u); } }
#pragma unroll
          for (int i = 0; i < 4; ++i) { const int t = tA + i; const int nw = (t + 1 < w) ? t + 1 : w; const float rn = 1.0f / (float)nw;
              float s[8];
#pragma unroll
              for (int e = 0; e < 8; ++e) s[e] = 0.f;
#pragma unroll
              for (int q = 0; q < 16; ++q) { if (q < w) {
#pragma unroll
                  for (int e = 0; e < 8; ++e) s[e] += rv[15 + i - q][e]; } }
              u4 ov; ov[0] = pk_bf16(s[0] * rn - rv[15 + i][0], s[1] * rn - rv[15 + i][1]); ov[1] = pk_bf16(s[2] * rn - rv[15 + i][2], s[3] * rn - rv[15 + i][3]);
              ov[2] = pk_bf16(s[4] * rn - rv[15 + i][4], s[5] * rn - rv[15 + i][5]); ov[3] = pk_bf16(s[6] * rn - rv[15 + i][6], s[7] * rn - rv[15 + i][7]);
              *(LAS u4*)(dL + (tg * 4 + i) * 264 + c0) = ov; } }
        __syncthreads();
        const bf16_t* wfr = WPF + ((size_t)(gi * 8 + wv) * 16) * 512 + lane * 8;
        f32x16 a0 = {}, a1 = {};
#pragma unroll
        for (int k0 = 0; k0 < 16; ++k0) { const bf16x8 wf = *(const bf16x8*)(wfr + k0 * 512);
            const bf16x8 d0 = *(const LAS bf16x8*)(dL + r32 * 264 + k0 * 16 + hi * 8), d1 = *(const LAS bf16x8*)(dL + (32 + r32) * 264 + k0 * 16 + hi * 8);
            a0 = __builtin_amdgcn_mfma_f32_32x32x16_bf16(wf, d0, a0, 0, 0, 0); a1 = __builtin_amdgcn_mfma_f32_32x32x16_bf16(wf, d1, a1, 0, 0, 0); }
#pragma unroll
        for (int a = 0; a < 4; ++a) { const int dout = gi * 256 + wv * 32 + 8 * a + 4 * hi; const f4 ps = *(const f4*)(pool_scale + dout);
            uint2 o; o.x = pk_bf16(a0[4 * a] * ps[0], a0[4 * a + 1] * ps[1]); o.y = pk_bf16(a0[4 * a + 2] * ps[2], a0[4 * a + 3] * ps[3]);
            *(uint2*)(MIX + (size_t)(tok0 + r32) * DM + dout) = o;
            o.x = pk_bf16(a1[4 * a] * ps[0], a1[4 * a + 1] * ps[1]); o.y = pk_bf16(a1[4 * a + 2] * ps[2], a1[4 * a + 3] * ps[3]);
            *(uint2*)(MIX + (size_t)(tok0 + 32 + r32) * DM + dout) = o; }
        __syncthreads();
    }
}
}
namespace att {
constexpr int D = 128, KVBLK = 64, QBLK = 32, SHM_V = KVBLK * D * 2, SHM_K = KVBLK * D * 2; constexpr float SCALE = 0.08838834764831845f, THR = 8.f; constexpr bool WSKIP = true;
typedef short s16x4 __attribute__((ext_vector_type(4))); typedef float f32x4 __attribute__((ext_vector_type(4))); typedef unsigned u32x4 __attribute__((ext_vector_type(4)));
#define KSWZ(row, colB) ((row) * 256 + ((colB) ^ (((row) & 7) << 4)))
#define SBAR() __builtin_amdgcn_sched_barrier(0)
__device__ __forceinline__ int v_st(int k, int c) { const int kk = (k & ~0xC) | ((k & 4) << 1) | ((k & 8) >> 1); return ((kk >> 3) * 4 + (c >> 5)) * 512 + ((kk & 7) * 32 + (c & 31)) * 2; }
__device__ __forceinline__ int v_rd_base(int lane) { return ((lane & 3) << 3) | (((lane >> 2) & 3) << 6) | (((lane >> 4) & 1) << 5) | (((lane >> 5) & 1) << 8); }
constexpr int v_rd_off(int d0, int ks, int half) { return d0 * 512 + ks * 4096 + half * 2048; }
__device__ __forceinline__ int crow(int r, int hi) { return (r & 3) + 8 * (r >> 2) + 4 * hi; }
__device__ __forceinline__ unsigned cvtpk(float lo, float hi) {
    unsigned r; asm volatile("v_cvt_pk_bf16_f32 %0, %1, %2" : "=v"(r) : "v"(lo), "v"(hi)); return r;
}
__device__ __forceinline__ bf16x8 pack8(f32x4 a, f32x4 b) {
    u32x4 w = {cvtpk(a[0], a[1]), cvtpk(a[2], a[3]), cvtpk(b[0], b[1]), cvtpk(b[2], b[3])};
    return *reinterpret_cast<bf16x8*>(&w);
}
__device__ __forceinline__ void mask_tile(f32x16& p0, f32x16& p1, int dq, unsigned W) {
    const float NEG = -__builtin_inff();
#pragma unroll
    for (int r = 0; r < 16; ++r) {
        const int c = (r & 3) + 8 * (r >> 2);
        if ((unsigned)(dq - c) >= W) p0[r] = NEG;
        if ((unsigned)(dq - c - 32) >= W) p1[r] = NEG;
    }
}
__device__ __forceinline__ void partialSM(f32x16& p0, f32x16& p1, float& m_reg, float& mn, float& alpha) {
    float pmax = p0[0]; for (int r = 1; r < 16; ++r) pmax = fmaxf(pmax, p0[r]); for (int r = 0; r < 16; ++r) pmax = fmaxf(pmax, p1[r]);
    { auto rr = __builtin_amdgcn_permlane32_swap(__float_as_uint(pmax), __float_as_uint(pmax), false, false);
      pmax = fmaxf(__uint_as_float(rr[0]), __uint_as_float(rr[1])); }
    constexpr float C2 = 1.4426950408889634f * SCALE;
    if (__builtin_expect(__all((pmax - m_reg) * SCALE <= THR), 1)) { mn = m_reg; alpha = 1.f; }
    else { mn = fmaxf(m_reg, pmax); alpha = __builtin_amdgcn_exp2f((m_reg - mn) * C2); m_reg = mn; }
    const float mnL = -mn * C2;
    for (int r = 0; r < 16; ++r) p0[r] = fmaf(p0[r], C2, mnL); for (int r = 0; r < 16; ++r) p1[r] = fmaf(p1[r], C2, mnL);
    for (int r = 0; r < 16; ++r) p0[r] = __builtin_amdgcn_exp2f(p0[r]);
}
__device__ __forceinline__ void finishSM(f32x16& p0, f32x16& p1, float alpha, float& l_reg, bf16x8& pa0, bf16x8& pa1, bf16x8& pa2, bf16x8& pa3) {
    for (int r = 0; r < 16; ++r) p1[r] = __builtin_amdgcn_exp2f(p1[r]);
    float ps = 0; for (int r = 0; r < 16; ++r) ps += p0[r]; for (int r = 0; r < 16; ++r) ps += p1[r];
    { auto rr = __builtin_amdgcn_permlane32_swap(__float_as_uint(ps), __float_as_uint(ps), false, false);
      ps = __uint_as_float(rr[0]) + __uint_as_float(rr[1]); }
    l_reg = l_reg * alpha + ps;
#define PK4(P, B_, OUT) do { unsigned a0 = cvtpk(P[B_+0], P[B_+1]), a1 = cvtpk(P[B_+2], P[B_+3]);                          \
        unsigned b0 = cvtpk(P[B_+4], P[B_+5]), b1 = cvtpk(P[B_+6], P[B_+7]);                                             \
        auto r0 = __builtin_amdgcn_permlane32_swap(a0, b0, false, false); auto r1 = __builtin_amdgcn_permlane32_swap(a1, b1, false, false); \
        u32x4 w = {r0[0], r1[0], r0[1], r1[1]}; OUT = *reinterpret_cast<bf16x8*>(&w); } while (0)
    PK4(p0, 0, pa0); PK4(p0, 8, pa1); PK4(p1, 0, pa2); PK4(p1, 8, pa3);
#undef PK4
}
template <int KB, bool SK>
__device__ __forceinline__ void qkt(f32x16& p0, f32x16& p1, const char* K_lds, int r32, int hi, const bf16x8* qr, bool act) {
    if (SK && !act) { const float NEG = -__builtin_inff();
#pragma unroll
        for (int r = 0; r < 16; ++r) { p0[r] = NEG; p1[r] = NEG; } return; }
    p0 = f32x16{}; p1 = f32x16{};
    const char* kb[4];
#pragma unroll
    for (int dd = 0; dd < 4; ++dd) kb[dd] = K_lds + KB * SHM_K + KSWZ(r32, (dd * 16 + hi * 8) * 2);
#pragma unroll
    for (int d0 = 0; d0 < 8; ++d0) { const char* a = kb[d0 & 3] + (d0 >> 2) * 128;
        bf16x8 b0 = *reinterpret_cast<const bf16x8*>(a);
        bf16x8 b1 = *reinterpret_cast<const bf16x8*>(a + 32 * 256);
        p0 = __builtin_amdgcn_mfma_f32_32x32x16_bf16(b0, qr[d0], p0, 0, 0, 0);
        p1 = __builtin_amdgcn_mfma_f32_32x32x16_bf16(b1, qr[d0], p1, 0, 0, 0); }
}
template <int VB, bool SK>
__device__ __forceinline__ void pv_tile(f32x16* o, int vb0, bf16x8 pa0, bf16x8 pa1, bf16x8 pa2, bf16x8 pa3, bool act) {
    if (SK && !act) return;
#define TRRD(dst, off) asm volatile("ds_read_b64_tr_b16 %0, %1 offset:%2" : "=&v"(dst) : "v"(vb0), "i"(off) : "memory")
#define PV_D0(d0) do { s16x4 l0, l1, l2, l3, h0, h1, h2, h3; constexpr int b_ = VB * SHM_V + v_rd_off(d0, 0, 0);     \
        TRRD(l0, b_); TRRD(h0, b_ + 2048); TRRD(l1, b_ + 4096); TRRD(h1, b_ + 6144); TRRD(l2, b_ + 8192); TRRD(h2, b_ + 10240); TRRD(l3, b_ + 12288); TRRD(h3, b_ + 14336); \
        asm volatile("s_waitcnt lgkmcnt(0)" ::: "memory"); SBAR();                 \
        o[d0] = __builtin_amdgcn_mfma_f32_32x32x16_bf16(pa0, (bf16x8){l0[0], l0[1], l0[2], l0[3], h0[0], h0[1], h0[2], h0[3]}, o[d0], 0, 0, 0);   \
        o[d0] = __builtin_amdgcn_mfma_f32_32x32x16_bf16(pa1, (bf16x8){l1[0], l1[1], l1[2], l1[3], h1[0], h1[1], h1[2], h1[3]}, o[d0], 0, 0, 0);   \
        o[d0] = __builtin_amdgcn_mfma_f32_32x32x16_bf16(pa2, (bf16x8){l2[0], l2[1], l2[2], l2[3], h2[0], h2[1], h2[2], h2[3]}, o[d0], 0, 0, 0);   \
        o[d0] = __builtin_amdgcn_mfma_f32_32x32x16_bf16(pa3, (bf16x8){l3[0], l3[1], l3[2], l3[3], h3[0], h3[1], h3[2], h3[3]}, o[d0], 0, 0, 0); } while (0)
    PV_D0(0); PV_D0(1); PV_D0(2); PV_D0(3);
#undef PV_D0
#undef TRRD
}
template <int VB, bool SK>
__device__ __forceinline__ void pv_tile_p(f32x16* o, int vb0, bf16x8 pa0, bf16x8 pa1, bf16x8 pa2, bf16x8 pa3, bool act) {
    if (SK && !act) return;
#define TRRD(dst, off) asm volatile("ds_read_b64_tr_b16 %0, %1 offset:%2" : "=&v"(dst) : "v"(vb0), "i"(off) : "memory")
#define PV_RD(X, d0) do { constexpr int b_ = VB * SHM_V + v_rd_off(d0, 0, 0); \
        TRRD(X##l0, b_); TRRD(X##h0, b_ + 2048); TRRD(X##l1, b_ + 4096); TRRD(X##h1, b_ + 6144); TRRD(X##l2, b_ + 8192); TRRD(X##h2, b_ + 10240); TRRD(X##l3, b_ + 12288); TRRD(X##h3, b_ + 14336); } while (0)
#define PV_MM(X, d0) do { \
        o[d0] = __builtin_amdgcn_mfma_f32_32x32x16_bf16(pa0, (bf16x8){X##l0[0], X##l0[1], X##l0[2], X##l0[3], X##h0[0], X##h0[1], X##h0[2], X##h0[3]}, o[d0], 0, 0, 0);   \
        o[d0] = __builtin_amdgcn_mfma_f32_32x32x16_bf16(pa1, (bf16x8){X##l1[0], X##l1[1], X##l1[2], X##l1[3], X##h1[0], X##h1[1], X##h1[2], X##h1[3]}, o[d0], 0, 0, 0);   \
        o[d0] = __builtin_amdgcn_mfma_f32_32x32x16_bf16(pa2, (bf16x8){X##l2[0], X##l2[1], X##l2[2], X##l2[3], X##h2[0], X##h2[1], X##h2[2], X##h2[3]}, o[d0], 0, 0, 0);   \
        o[d0] = __builtin_amdgcn_mfma_f32_32x32x16_bf16(pa3, (bf16x8){X##l3[0], X##l3[1], X##l3[2], X##l3[3], X##h3[0], X##h3[1], X##h3[2], X##h3[3]}, o[d0], 0, 0, 0); } while (0)
    s16x4 Al0, Al1, Al2, Al3, Ah0, Ah1, Ah2, Ah3, Bl0, Bl1, Bl2, Bl3, Bh0, Bh1, Bh2, Bh3;
    PV_RD(A, 0); PV_RD(B, 1);
    asm volatile("s_waitcnt lgkmcnt(8)" ::: "memory"); SBAR(); PV_MM(A, 0); SBAR();
    PV_RD(A, 2);
    asm volatile("s_waitcnt lgkmcnt(8)" ::: "memory"); SBAR(); PV_MM(B, 1); SBAR();
    PV_RD(B, 3);
    asm volatile("s_waitcnt lgkmcnt(8)" ::: "memory"); SBAR(); PV_MM(A, 2); SBAR();
    asm volatile("s_waitcnt lgkmcnt(0)" ::: "memory"); SBAR(); PV_MM(B, 3);
#undef PV_MM
#undef PV_RD
#undef TRRD
}
template <int KB>
__device__ __forceinline__ void qkt_p(f32x16& p0, f32x16& p1, const char* K_lds, int r32, int hi, const bf16x8* qr) {
    p0 = f32x16{}; p1 = f32x16{};
    const char* kb[4];
#pragma unroll
    for (int dd = 0; dd < 4; ++dd) kb[dd] = K_lds + KB * SHM_K + KSWZ(r32, (dd * 16 + hi * 8) * 2);
#define QK_RD(X, g) do { _Pragma("unroll") for (int e = 0; e < 2; ++e) { const int d0 = (g) * 2 + e; const char* a = kb[d0 & 3] + (d0 >> 2) * 128; \
        X##0[e] = *reinterpret_cast<const bf16x8*>(a); X##1[e] = *reinterpret_cast<const bf16x8*>(a + 32 * 256); } } while (0)
#define QK_MM(X, g) do { _Pragma("unroll") for (int e = 0; e < 2; ++e) { const int d0 = (g) * 2 + e; \
        p0 = __builtin_amdgcn_mfma_f32_32x32x16_bf16(X##0[e], qr[d0], p0, 0, 0, 0); p1 = __builtin_amdgcn_mfma_f32_32x32x16_bf16(X##1[e], qr[d0], p1, 0, 0, 0); } } while (0)
    bf16x8 X0[2], X1[2], Y0[2], Y1[2];
    QK_RD(X, 0); QK_RD(Y, 1); SBAR();
    QK_MM(X, 0); SBAR(); QK_RD(X, 2); SBAR();
    QK_MM(Y, 1); SBAR(); QK_RD(Y, 3); SBAR();
    QK_MM(X, 2); SBAR(); QK_MM(Y, 3);
#undef QK_RD
#undef QK_MM
}
}
#ifndef MK_BR_MASK
#define MK_BR_MASK 7
#endif
#define BRM_C ((MK_BR_MASK & 1) ? 1.f : 0.f)
#define BRM_S ((MK_BR_MASK & 2) ? 1.f : 0.f)
#define BRM_W ((MK_BR_MASK & 4) ? 1.f : 0.f)
namespace {
using att::crow; using att::SHM_K; using att::SHM_V;
struct KVStage { bf16x8 k0, k1, v0, v1; };
__device__ __forceinline__ void kv_load(KVStage& S, const bf16_t* K, int kstride, const bf16_t* V, int vstride, int kb, int sr, int sc) {
    const bf16_t* kt = K + (size_t)kb * kstride; const bf16_t* vt = V + (size_t)kb * vstride;
    const unsigned ko = (unsigned)(sr * kstride + sc), vo = (unsigned)(sr * vstride + sc);
    S.k0 = *(const bf16x8*)(kt + ko); S.k1 = *(const bf16x8*)(kt + (ko + 32u * (unsigned)kstride));
    S.v0 = *(const bf16x8*)(vt + vo); S.v1 = *(const bf16x8*)(vt + (vo + 32u * (unsigned)vstride));
}
template <int BUF> __device__ __forceinline__ void kv_write(const KVStage& S, LAS unsigned char* V_lds, LAS unsigned char* K_lds, int kws, int vst0, int vst1) {
    *(LAS bf16x8*)(K_lds + BUF * SHM_K + kws) = S.k0; *(LAS bf16x8*)(K_lds + BUF * SHM_K + kws + 32 * 256) = S.k1;
    *(LAS bf16x8*)(V_lds + BUF * SHM_V + vst0) = S.v0; *(LAS bf16x8*)(V_lds + BUF * SHM_V + vst1) = S.v1;
}
__device__ __forceinline__ void pack_P(const f32x16& p0, const f32x16& p1, bf16x8& pa0, bf16x8& pa1, bf16x8& pa2, bf16x8& pa3) {
#define PK4(P, B_, OUT) do { unsigned a0 = att::cvtpk(P[B_+0], P[B_+1]), a1 = att::cvtpk(P[B_+2], P[B_+3]); unsigned b0 = att::cvtpk(P[B_+4], P[B_+5]), b1 = att::cvtpk(P[B_+6], P[B_+7]); \
        auto r0 = __builtin_amdgcn_permlane32_swap(a0, b0, false, false); auto r1 = __builtin_amdgcn_permlane32_swap(a1, b1, false, false); \
        att::u32x4 w = {r0[0], r1[0], r0[1], r1[1]}; OUT = *reinterpret_cast<bf16x8*>(&w); } while (0)
    PK4(p0, 0, pa0); PK4(p0, 8, pa1); PK4(p1, 0, pa2); PK4(p1, 8, pa3);
#undef PK4
}
__device__ __forceinline__ void load_q_raw(uint4 (&raw)[8], const bf16_t* PROJ, int tok, int hq, int hi) {
    const bf16_t* qp = PROJ + (size_t)tok * PLD + QOFF + hq * 128 + hi * 8;
#pragma unroll
    for (int d0 = 0; d0 < 8; ++d0) raw[d0] = *(const uint4*)(qp + d0 * 16);
}
template <bool ROPE> __device__ __forceinline__ void finish_q(bf16x8 (&qf)[8], const uint4 (&raw)[8], int t, int hi, const float* q_norm_g, const float* rope) {
    float ss = 0.f;
#pragma unroll
    for (int d0 = 0; d0 < 8; ++d0) { const unsigned uu[4] = {raw[d0].x, raw[d0].y, raw[d0].z, raw[d0].w};
#pragma unroll
        for (int e = 0; e < 4; ++e) { const float lo = __uint_as_float(uu[e] << 16), h2 = __uint_as_float(uu[e] & 0xffff0000u); ss += lo * lo + h2 * h2; } }
    ss += __shfl_xor(ss, 32);
    const float rstd = rsqrtf(ss * (1.0f / 128.f) + 1e-6f);
#pragma unroll
    for (int d0 = 0; d0 < 4; ++d0) {
        float ya[8], yb[8];
        { const unsigned ua[4] = {raw[d0].x, raw[d0].y, raw[d0].z, raw[d0].w}, ub[4] = {raw[d0 + 4].x, raw[d0 + 4].y, raw[d0 + 4].z, raw[d0 + 4].w};
          const float* gp = q_norm_g + d0 * 16 + hi * 8; const f4 ga0 = *(const f4*)gp, ga1 = *(const f4*)(gp + 4), gb0 = *(const f4*)(gp + 64), gb1 = *(const f4*)(gp + 68);
#pragma unroll
          for (int e = 0; e < 4; ++e) { const float g_a0 = e < 2 ? ga0[2 * e] : ga1[2 * e - 4], g_a1 = e < 2 ? ga0[2 * e + 1] : ga1[2 * e - 3], g_b0 = e < 2 ? gb0[2 * e] : gb1[2 * e - 4], g_b1 = e < 2 ? gb0[2 * e + 1] : gb1[2 * e - 3];
              ya[2 * e] = __uint_as_float(ua[e] << 16) * rstd * g_a0; ya[2 * e + 1] = __uint_as_float(ua[e] & 0xffff0000u) * rstd * g_a1;
              yb[2 * e] = __uint_as_float(ub[e] << 16) * rstd * g_b0; yb[2 * e + 1] = __uint_as_float(ub[e] & 0xffff0000u) * rstd * g_b1; } }
        if (ROPE) { const float* cp = rope + t * 64 + d0 * 16 + hi * 8; const float* sp = cp + NT * 64;
            const f4 c0 = *(const f4*)cp, c1 = *(const f4*)(cp + 4), s0 = *(const f4*)sp, s1 = *(const f4*)(sp + 4);
#pragma unroll
            for (int e = 0; e < 8; ++e) { const float cs = e < 4 ? c0[e & 3] : c1[e & 3], sn = e < 4 ? s0[e & 3] : s1[e & 3]; const float a = ya[e], b = yb[e]; ya[e] = a * cs - b * sn; yb[e] = b * cs + a * sn; } }
        { att::u32x4 w = {att::cvtpk(ya[0], ya[1]), att::cvtpk(ya[2], ya[3]), att::cvtpk(ya[4], ya[5]), att::cvtpk(ya[6], ya[7])}; qf[d0] = *reinterpret_cast<bf16x8*>(&w); }
        { att::u32x4 w = {att::cvtpk(yb[0], yb[1]), att::cvtpk(yb[2], yb[3]), att::cvtpk(yb[4], yb[5]), att::cvtpk(yb[6], yb[7])}; qf[d0 + 4] = *reinterpret_cast<bf16x8*>(&w); }
        __builtin_amdgcn_sched_barrier(0);
    }
}

template <bool ROPE> __device__ __forceinline__ void load_q(bf16x8 (&qf)[8], const bf16_t* PROJ, int tok, int t, int hq, int hi, const float* q_norm_g, const float* rope) {
    uint4 raw[8]; load_q_raw(raw, PROJ, tok, hq, hi); finish_q<ROPE>(qf, raw, t, hi, q_norm_g, rope);
}

__device__ __forceinline__ void p4a_cmp(const bf16_t* PROJ, const bf16_t* CMPK, const bf16_t* CMPV, const float* q_norm_g, bf16_t* OC, unsigned* SELM, LAS unsigned char* lds, int blk, int nblk) {
    const int tid = threadIdx.x, wid = __builtin_amdgcn_readfirstlane(tid >> 6), lane = tid & 63, r32 = lane & 31, hi = lane >> 5;
    LAS unsigned char* V_lds = lds; LAS unsigned char* K_lds = lds + 2 * SHM_V;
    LAS float* wsf = (LAS float*)(lds + 2 * SHM_V + 2 * SHM_K) + wid * 64;
    const int sr = tid >> 4, sc = (tid & 15) * 8, vst0 = att::v_st(sr, sc), vst1 = att::v_st(32 + sr, sc), kws = KSWZ(sr, sc * 2);
    const int vb0 = (int)(size_t)V_lds + att::v_rd_base(lane);
    for (int item = blk; item < 256; item += nblk) {
        const int tb = item & 7, g = (item >> 3) & 3, b = item >> 5;
        const bf16_t* Kc = CMPK + ((size_t)b * 4 + g) * 128 * 128; const bf16_t* Vc = CMPV + ((size_t)b * 4 + g) * 128 * 128;
        { KVStage S; kv_load(S, Kc, 128, Vc, 128, 0, sr, sc); kv_write<0>(S, V_lds, K_lds, kws, vst0, vst1); kv_load(S, Kc, 128, Vc, 128, 64, sr, sc); kv_write<1>(S, V_lds, K_lds, kws, vst0, vst1); }
        __syncthreads();
        const int t = tb * 256 + wid * 32 + r32, tok = b * NT + t;
        const int nv = t >= 31 ? ((t - 31) / 16 + 1 > NCMP ? NCMP : (t - 31) / 16 + 1) : 0;
        float impA[16];
#pragma unroll
        for (int i = 0; i < 16; ++i) impA[i] = 0.f;
#pragma unroll 1
        for (int r6 = 0; r6 < 6; ++r6) {
            const int hq = g * 6 + r6;
            bf16x8 qf[8]; load_q<false>(qf, PROJ, tok, t, hq, hi, q_norm_g, nullptr);
            f32x16 P[2][2];
            att::qkt<0, false>(P[0][0], P[0][1], (const char*)K_lds, r32, hi, qf, true);
            att::qkt<1, false>(P[1][0], P[1][1], (const char*)K_lds, r32, hi, qf, true);
            float mx = -INFINITY;
#pragma unroll
            for (int T = 0; T < 2; ++T)
#pragma unroll
                for (int hf = 0; hf < 2; ++hf)
#pragma unroll
                    for (int r = 0; r < 16; ++r) { const int n = T * 64 + hf * 32 + (r & 3) + 8 * (r >> 2) + 4 * hi; const float s = (n < nv) ? P[T][hf][r] * SCALE : -INFINITY; P[T][hf][r] = s; mx = fmaxf(mx, s); }
            mx = fmaxf(mx, __shfl_xor(mx, 32)); if (!(mx > -INFINITY)) mx = 0.f;
            float sum = 0.f;
#pragma unroll
            for (int T = 0; T < 2; ++T)
#pragma unroll
                for (int hf = 0; hf < 2; ++hf)
#pragma unroll
                    for (int r = 0; r < 16; ++r) { const float p = __expf(P[T][hf][r] - mx); P[T][hf][r] = p; sum += p; }
            sum += __shfl_xor(sum, 32);
            const float gc = sigmoidf_(bf2f(PROJ[(size_t)tok * PLD + GOFF + hq * 3 + 0]));
            const float inv = sum > 0.f ? 1.0f / sum : 0.f;
            float bv[16];
            bf16x8 pa[2][4];
#pragma unroll
            for (int T = 0; T < 2; ++T) {
#pragma unroll
                for (int hf = 0; hf < 2; ++hf)
#pragma unroll
                    for (int a = 0; a < 4; ++a) { const float p0 = P[T][hf][4 * a], p1 = P[T][hf][4 * a + 1], p2 = P[T][hf][4 * a + 2], p3 = P[T][hf][4 * a + 3];
                        impA[(T * 2 + hf) * 4 + a] += ((p0 + p1) + (p2 + 0.5f * p3)) * inv; bv[(T * 2 + hf) * 4 + a] = 0.5f * p3 * inv; }
                pack_P(P[T][0], P[T][1], pa[T][0], pa[T][1], pa[T][2], pa[T][3]);
            }
            { float prev = 0.f;
#pragma unroll
              for (int i = 0; i < 16; ++i) { const float bp = __shfl_xor(bv[i], 32); impA[i] += hi ? bp : prev; prev = bp; } }
            asm volatile("" ::: "memory"); __builtin_amdgcn_sched_barrier(0);
            f32x16 o[4] = {};
            att::pv_tile<0, false>(o, vb0, pa[0][0], pa[0][1], pa[0][2], pa[0][3], true);
            att::pv_tile<1, false>(o, vb0, pa[1][0], pa[1][1], pa[1][2], pa[1][3], true);
            if (hi == 0) wsf[r32] = gc * inv * BRM_C;
            asm volatile("s_waitcnt lgkmcnt(0)" ::: "memory");
            bf16_t* Ow = OC + (size_t)(b * NT + tb * 256 + wid * 32) * 3072 + hq * 128; asm volatile("" : "+v"(Ow));
#pragma unroll
            for (int r = 0; r < 16; ++r) { int hl = hi; asm volatile("" : "+v"(hl)); const int orow = crow(r, hl); const float f = wsf[orow];
#pragma unroll
                for (int d0 = 0; d0 < 4; ++d0) Ow[(size_t)orow * 3072 + d0 * 32 + r32] = (bf16_t)(att::cvtpk(o[d0][r] * f, 0.f) & 0xffffu);
                if ((r & 3) == 3) __builtin_amdgcn_sched_barrier(0); }
            asm volatile("s_waitcnt lgkmcnt(0)" ::: "memory");
        }
        float imp[32];
#pragma unroll
        for (int i = 0; i < 16; ++i) { const float oth = __shfl_xor(impA[i], 32); imp[2 * i] = hi ? oth : impA[i]; imp[2 * i + 1] = hi ? impA[i] : oth; }
        const int cur = t >> 6;
        int ka[16], kb2[16];
#pragma unroll
        for (int j = 0; j < 32; ++j) { const bool forced = (j == 0) || (j == cur) || (j == cur - 1); const bool valid = (j * 64) <= t;
            const float scv = valid ? imp[j] + (forced ? 1000.f : 0.f) : -1e9f; const int key = (f2key(scv) & ~31) | (31 - j);
            if (j < 16) ka[j] = key; else kb2[j - 16] = key; }
        sort16_desc(ka); sort16_desc(kb2);
        unsigned mask = 0u;
#pragma unroll
        for (int i = 0; i < 16; ++i) { const int m = max(ka[i], kb2[15 - i]); mask |= 1u << (31 - (m & 31)); }
        if (hi == 0) SELM[(size_t)tok * 4 + g] = mask;
        __syncthreads();
    }
}
}
namespace {
template <bool SEL>
__device__ __forceinline__ void attn_branch(f32x16 (&o)[4], float& l_out, const bf16x8 (&qf)[8], KVStage& S, const bf16_t* K, const bf16_t* V, int j_lo, int j_hi, const bf16_t* nK, const bf16_t* nV, int n_jlo, int qlo, int qm, unsigned selm,
                                            LAS unsigned char* V_lds, LAS unsigned char* K_lds, LAS float* al_l, int vb0, int sr, int sc, int kws, int vst0, int vst1, int r32, int hi) {
    constexpr int W = 512;
    float m_reg = -1e30f, l_reg = 0.f;
#pragma unroll
    for (int d = 0; d < 4; ++d) o[d] = f32x16{};
    kv_write<0>(S, V_lds, K_lds, kws, vst0, vst1);
    __syncthreads();
#define ATT_TILE(BUF, tj) do { const int kb_ = (tj) * 64; const bool more_ = (tj) + 1 < j_hi; \
        if (more_) kv_load(S, K, 128, V, PLD, kb_ + 64, sr, sc); else kv_load(S, nK, 128, nV, PLD, n_jlo * 64, sr, sc); \
        bool act_ = kb_ <= qlo + 31; \
        if (SEL) act_ = act_ && (__builtin_amdgcn_ballot_w64(((selm >> (tj)) & 1u) != 0u) != 0ull); else act_ = act_ && (kb_ + 63 >= qlo - W + 1); \
        if (act_) { f32x16 p0, p1; att::qkt_p<BUF>(p0, p1, (const char*)K_lds, r32, hi, qf); \
            if (SEL) { if (kb_ + 63 > qlo) att::mask_tile(p0, p1, qm - kb_, 0x7fffffffu); \
                       if (((selm >> (tj)) & 1u) == 0u) { _Pragma("unroll") for (int r = 0; r < 16; ++r) { p0[r] = -INFINITY; p1[r] = -INFINITY; } } } \
            else { if (kb_ + 63 > qlo || kb_ <= qlo + 31 - W) att::mask_tile(p0, p1, qm - kb_, (unsigned)W); } \
            float mn_, al_; att::partialSM(p0, p1, m_reg, mn_, al_); bf16x8 pa0, pa1, pa2, pa3; att::finishSM(p0, p1, al_, l_reg, pa0, pa1, pa2, pa3); \
            if (__any(al_ < 1.f)) { if (hi == 0) al_l[r32] = al_; asm volatile("s_waitcnt lgkmcnt(0)" ::: "memory"); \
                _Pragma("unroll") for (int d_ = 0; d_ < 4; ++d_) _Pragma("unroll") for (int r = 0; r < 16; ++r) o[d_][r] *= al_l[crow(r, hi)]; } \
            att::pv_tile_p<BUF, false>(o, vb0, pa0, pa1, pa2, pa3, true); } \
        if (more_) kv_write<1 - BUF>(S, V_lds, K_lds, kws, vst0, vst1); \
        __syncthreads(); } while (0)
#pragma unroll 1
    for (int tj = j_lo; tj < j_hi; tj += 2) {
        ATT_TILE(0, tj);
        if (tj + 1 < j_hi) ATT_TILE(1, tj + 1);
    }
#undef ATT_TILE
    l_out = l_reg;
}
__device__ __forceinline__ void p4b_attn(const bf16_t* PROJ, const bf16_t* KSEL, const bf16_t* KWIN, const unsigned* SELM, const bf16_t* OC, const float* rope, const float* q_norm_g, bf16_t* MIX,
                                         LAS unsigned char* lds, int blk, int nblk) {
    const int tid = threadIdx.x, wid = __builtin_amdgcn_readfirstlane(tid >> 6), lane = tid & 63, r32 = lane & 31, hi = lane >> 5;
    LAS unsigned char* V_lds = lds; LAS unsigned char* K_lds = lds + 2 * SHM_V;
    LAS float* wsf = (LAS float*)(lds + 2 * SHM_V + 2 * SHM_K) + wid * 64;
    LAS bf16_t* ost = (LAS bf16_t*)(lds + 2 * SHM_V + 2 * SHM_K + 2048) + wid * 32 * 136;
    const int sr = tid >> 4, sc = (tid & 15) * 8, vst0 = att::v_st(sr, sc), vst1 = att::v_st(32 + sr, sc), kws = KSWZ(sr, sc * 2);
    const int vb0 = (int)(size_t)V_lds + att::v_rd_base(lane);
#define P4B_ITEM(mm, qb_, b_, hq_) const int idx##mm = (mm) * 256 + (((mm) & 1) ? (nblk - 1 - blk) : blk); const int qb_ = 7 - idx##mm / 192, b_ = (idx##mm % 192) / 24, hq_ = (idx##mm % 192) % 24
#define P4B_KSEL(b_, hq_) (KSEL + ((size_t)(b_) * 4 + (hq_) / 6) * NT * 128)
#define P4B_VSEL(b_, hq_) (PROJ + (size_t)(b_) * NT * PLD + KVOFF + ((1 * 2 + 1) * 4 + (hq_) / 6) * 128)
    KVStage S;
    { P4B_ITEM(0, qb0, b0, hq0); (void)qb0; kv_load(S, P4B_KSEL(b0, hq0), 128, P4B_VSEL(b0, hq0), PLD, 0, sr, sc); }
#pragma unroll 1
    for (int m = 0; m < 6; ++m) {
        P4B_ITEM(m, qb, b, hq); const int g = hq / 6;
        const int mn = m + 1 < 6 ? m + 1 : m; P4B_ITEM(mn, qbn, bn, hqn); (void)qbn;
        const int P0 = qb * 256, qlo = P0 + wid * 32, t = qlo + r32, tok = b * NT + t, qm = t - 4 * hi;
        bf16x8 qf[8]; load_q<true>(qf, PROJ, tok, t, hq, hi, q_norm_g, rope);
        const unsigned selm = SELM[(size_t)tok * 4 + g];
        const float gs = sigmoidf_(bf2f(PROJ[(size_t)tok * PLD + GOFF + hq * 3 + 1])), gwv = sigmoidf_(bf2f(PROJ[(size_t)tok * PLD + GOFF + hq * 3 + 2]));
        const int j_hi = qb * 4 + 4;
        f32x16 o[4]; float lsum;
        const int jl = (P0 - 511 > 0) ? (P0 - 511) / 64 : 0;
        const bf16_t* Kw = KWIN + ((size_t)b * 4 + g) * NT * 128; const bf16_t* Vw = PROJ + (size_t)b * NT * PLD + KVOFF + ((2 * 2 + 1) * 4 + g) * 128;
        attn_branch<true>(o, lsum, qf, S, P4B_KSEL(b, hq), P4B_VSEL(b, hq), 0, j_hi, Kw, Vw, jl, qlo, qm, selm,
                          V_lds, K_lds, wsf + 32, vb0, sr, sc, kws, vst0, vst1, r32, hi);
        if (hi == 0) wsf[r32] = BRM_S * gs / lsum;
        asm volatile("s_waitcnt lgkmcnt(0)" ::: "memory");
#pragma unroll
        for (int r = 0; r < 16; ++r) { int hl = hi; asm volatile("" : "+v"(hl)); const int orow = crow(r, hl); const float f = wsf[orow];
#pragma unroll
            for (int d0 = 0; d0 < 4; ++d0) ost[orow * 136 + d0 * 32 + r32] = (bf16_t)(att::cvtpk(o[d0][r] * f, 0.f) & 0xffffu); }
        attn_branch<false>(o, lsum, qf, S, Kw, Vw, jl, j_hi, P4B_KSEL(bn, hqn), P4B_VSEL(bn, hqn), 0, qlo, qm, 0u,
                           V_lds, K_lds, wsf + 32, vb0, sr, sc, kws, vst0, vst1, r32, hi);
        if (hi == 0) wsf[r32] = BRM_W * gwv / lsum;
        asm volatile("s_waitcnt lgkmcnt(0)" ::: "memory");
#pragma unroll
        for (int r = 0; r < 16; ++r) { int hl = hi; asm volatile("" : "+v"(hl)); const int orow = crow(r, hl); const float f = wsf[orow];
#pragma unroll
            for (int d0 = 0; d0 < 4; ++d0) { LAS bf16_t* p = ost + orow * 136 + d0 * 32 + r32; *p = (bf16_t)(att::cvtpk(o[d0][r] * f + bf2f(*p), 0.f) & 0xffffu); } }
        asm volatile("s_waitcnt lgkmcnt(0)" ::: "memory");
        const size_t rowbase = (size_t)(b * NT + qlo);
#pragma unroll
        for (int i = 0; i < 8; ++i) { const int ch = i * 64 + lane, row = ch >> 4, c8 = (ch & 15) * 8;
            const u4 sv = *(const LAS u4*)(ost + row * 136 + c8); const uint4 cv = *(const uint4*)(OC + (rowbase + row) * 3072 + hq * 128 + c8);
            const unsigned s4[4] = {sv[0], sv[1], sv[2], sv[3]}, c4[4] = {cv.x, cv.y, cv.z, cv.w}; unsigned o4[4];
#pragma unroll
            for (int e = 0; e < 4; ++e) o4[e] = att::cvtpk(__uint_as_float(s4[e] << 16) + __uint_as_float(c4[e] << 16), __uint_as_float(s4[e] & 0xffff0000u) + __uint_as_float(c4[e] & 0xffff0000u));
            *(uint4*)(MIX + (rowbase + row) * DM + 1024 + hq * 128 + c8) = make_uint4(o4[0], o4[1], o4[2], o4[3]);
            if (i & 1) __builtin_amdgcn_sched_barrier(0); }
        __syncthreads();
    }
#undef P4B_ITEM
#undef P4B_KSEL
#undef P4B_VSEL
}
}
namespace {
typedef float f2v __attribute__((ext_vector_type(2)));
constexpr size_t WS_USC = WS_END_C;
constexpr size_t WS_VSC = WS_USC + 65536;
constexpr size_t WS_END_F = WS_VSC + 65536;
constexpr size_t PEER8_SLAB = (size_t)16384 * 128;

__device__ __forceinline__ unsigned pk4_fp8(float a, float b, float c, float d) { int p = __builtin_amdgcn_cvt_pk_fp8_f32(a, b, 0, false); p = __builtin_amdgcn_cvt_pk_fp8_f32(c, d, p, true); return (unsigned)p; }

__device__ __forceinline__ void p0_peer_cvt8(const float* src, unsigned char* dst, float* scale, int blk, int nblk) {
    const int tid = threadIdx.x, w = tid >> 6, lane = tid & 63, step = nblk * NWAVES;
    int e = blk * NWAVES + w; if (e >= 16384) return;
    float4 v[4][4];
#define CV_LOAD(X, ee) do { const float* r_ = src + (size_t)(ee) * DM + lane * 16; \
        _Pragma("unroll") for (int i = 0; i < 4; ++i) _Pragma("unroll") for (int q = 0; q < 4; ++q) X[i][q] = *(const float4*)(r_ + i * 1024 + q * 4); } while (0)
    CV_LOAD(v, e);
#pragma unroll 1
    for (; e < 16384; e += step) {
        float4 nv[4][4];
        const int en = e + step < 16384 ? e + step : e;
        CV_LOAD(nv, en);
        float m = 0.f;
#pragma unroll
        for (int i = 0; i < 4; ++i)
#pragma unroll
            for (int q = 0; q < 4; ++q) m = fmaxf(m, fmaxf(fmaxf(fabsf(v[i][q].x), fabsf(v[i][q].y)), fmaxf(fabsf(v[i][q].z), fabsf(v[i][q].w))));
        m = wave_max(m);
        const float inv = m > 0.f ? 448.0f / m : 1.0f;
        if (lane == 0) scale[e] = m > 0.f ? m * (1.0f / 448.0f) : 1.0f;
#pragma unroll
        for (int i = 0; i < 4; ++i) { uint4 o;
            o.x = pk4_fp8(v[i][0].x * inv, v[i][0].y * inv, v[i][0].z * inv, v[i][0].w * inv); o.y = pk4_fp8(v[i][1].x * inv, v[i][1].y * inv, v[i][1].z * inv, v[i][1].w * inv);
            o.z = pk4_fp8(v[i][2].x * inv, v[i][2].y * inv, v[i][2].z * inv, v[i][2].w * inv); o.w = pk4_fp8(v[i][3].x * inv, v[i][3].y * inv, v[i][3].z * inv, v[i][3].w * inv);
            const int c = i * 8 + (lane >> 3);
            *(uint4*)(dst + ((size_t)c * 16384 + e) * 128 + (lane & 7) * 16) = o; }
#pragma unroll
        for (int i = 0; i < 4; ++i)
#pragma unroll
            for (int q = 0; q < 4; ++q) v[i][q] = nv[i][q];
    }
#undef CV_LOAD
}

__device__ __forceinline__ unsigned nib(float x) { return (unsigned)__float2int_rn(fminf(fmaxf(x, -7.f), 7.f)) & 15u; }
__device__ __forceinline__ unsigned pk8_i4(float4 a, float4 b, float inv) {
    return nib(a.x * inv) | (nib(a.y * inv) << 4) | (nib(a.z * inv) << 8) | (nib(a.w * inv) << 12) | (nib(b.x * inv) << 16) | (nib(b.y * inv) << 20) | (nib(b.z * inv) << 24) | (nib(b.w * inv) << 28); }
__device__ __forceinline__ void p0_peer_cvt_i4(const float* src, unsigned char* dst, float* scale, int blk, int nblk) {
    const int tid = threadIdx.x, w = tid >> 6, lane = tid & 63, step = nblk * NWAVES;
    int e = blk * NWAVES + w; if (e >= 16384) return;
    float4 v[4][4];
#define CV_LOAD(X, ee) do { const float* r_ = src + (size_t)(ee) * DM + lane * 16; \
        _Pragma("unroll") for (int i = 0; i < 4; ++i) _Pragma("unroll") for (int q = 0; q < 4; ++q) X[i][q] = *(const float4*)(r_ + i * 1024 + q * 4); } while (0)
    CV_LOAD(v, e);
#pragma unroll 1
    for (; e < 16384; e += step) {
        float4 nv[4][4];
        const int en = e + step < 16384 ? e + step : e;
        CV_LOAD(nv, en);
        float m = 0.f, ss = 0.f;
#pragma unroll
        for (int i = 0; i < 4; ++i)
#pragma unroll
            for (int q = 0; q < 4; ++q) { m = fmaxf(m, fmaxf(fmaxf(fabsf(v[i][q].x), fabsf(v[i][q].y)), fmaxf(fabsf(v[i][q].z), fabsf(v[i][q].w))));
                ss += v[i][q].x * v[i][q].x + v[i][q].y * v[i][q].y + v[i][q].z * v[i][q].z + v[i][q].w * v[i][q].w; }
        m = wave_max(m); ss = wave_sum(ss);
        const float clipv = fminf(m, 2.6f * sqrtf(ss * (1.0f / DM))), sc = clipv * (1.0f / 7.0f);
        const float inv = sc > 0.f ? 1.0f / sc : 0.f;
        if (lane == 0) scale[e] = sc;
#pragma unroll
        for (int i = 0; i < 4; ++i) { uint2 o; o.x = pk8_i4(v[i][0], v[i][1], inv); o.y = pk8_i4(v[i][2], v[i][3], inv);
            const int c = i * 4 + (lane >> 4);
            *(uint2*)(dst + ((size_t)c * 16384 + e) * 128 + (lane & 15) * 8) = o; }
#pragma unroll
        for (int i = 0; i < 4; ++i)
#pragma unroll
            for (int q = 0; q < 4; ++q) v[i][q] = nv[i][q];
    }
#undef CV_LOAD
}

__device__ __forceinline__ void p10_peer_u8v(const unsigned char* Hq, const float* hqs, const unsigned char* U8, const float* USC, const float* VSC, const unsigned* eidx, const float* gw, LAS unsigned char* lds, int blk) {
    const int tid = threadIdx.x, wv = tid >> 6, lane = tid & 63, tl = lane >> 3, j = lane & 7;
    LAS unsigned* eo = (LAS unsigned*)lds;
    const int base = blk * 64;
    for (int i = tid; i < 64 * 128; i += NTHR) eo[i] = eidx[(size_t)base * 128 + i] * 128u;
    __syncthreads();
    const int tok = base + wv * 8 + tl;
    const LAS unsigned* myeo = eo + (wv * 8 + tl) * 128;
    const __amdgpu_buffer_rsrc_t urs = __builtin_amdgcn_make_buffer_rsrc((void*)U8, 0, 0x7fffffff, 0x00020000);
    int acc[128];
#pragma unroll
    for (int k = 0; k < 128; ++k) acc[k] = 0;
    const unsigned char* hrow = Hq + (size_t)tok * DM + j * 32;
    uint4 ub[2][8];
#define U8V_LOAD(g, B, cc) do { const int so_ = (cc) * (int)PEER8_SLAB; \
        _Pragma("unroll") for (int q = 0; q < 4; ++q) { ub[B][q] = __builtin_bit_cast(uint4, __builtin_amdgcn_raw_buffer_load_b128(urs, (int)ofa[q] + j * 16, so_, 0)); \
            ub[B][4 + q] = __builtin_bit_cast(uint4, __builtin_amdgcn_raw_buffer_load_b128(urs, (int)ofb[q] + j * 16, so_, 0)); } \
        ofa = *(const LAS u4*)(me + ((((g) + 1) & 15) * 8)); ofb = *(const LAS u4*)(me + ((((g) + 1) & 15) * 8) + 4);     \
        asm volatile("" ::: "memory"); __builtin_amdgcn_sched_barrier(0); } while (0)
#define U8V_DOT(g, B) do { _Pragma("unroll") for (int q = 0; q < 8; ++q) { int a = acc[(g) * 8 + q], t = 0; const unsigned uu[4] = {ub[B][q].x, ub[B][q].y, ub[B][q].z, ub[B][q].w}; \
        _Pragma("unroll") for (int d = 0; d < 4; ++d) { t = __builtin_amdgcn_sdot8((int)uu[d], (int)hv[2 * d], t, false); a = __builtin_amdgcn_sdot8((int)uu[d], (int)hv[2 * d + 1], a, false); } \
        acc[(g) * 8 + q] = a + (t << 4); } __builtin_amdgcn_sched_barrier(0); } while (0)
    const LAS unsigned* me = myeo;
    u4 ofa = *(const LAS u4*)me, ofb = *(const LAS u4*)(me + 4);
    uint4 hn0 = *(const uint4*)hrow, hn1 = *(const uint4*)(hrow + 16);
    U8V_LOAD(0, 0, 0);
#pragma unroll 1
    for (int c = 0; c < 16; ++c) {
        asm volatile("" : "+v"(me));
        const uint4 h0 = hn0, h1 = hn1;
        { const int cn = c + 1 < 16 ? c + 1 : c; hn0 = *(const uint4*)(hrow + cn * 256); hn1 = *(const uint4*)(hrow + cn * 256 + 16); }
        const unsigned hv[8] = {h0.x, h0.y, h0.z, h0.w, h1.x, h1.y, h1.z, h1.w};
        U8V_LOAD(1, 1, c); U8V_DOT(0, 0);
        U8V_LOAD(2, 0, c); U8V_DOT(1, 1);
        U8V_LOAD(3, 1, c); U8V_DOT(2, 0);
        U8V_LOAD(4, 0, c); U8V_DOT(3, 1);
        U8V_LOAD(5, 1, c); U8V_DOT(4, 0);
        U8V_LOAD(6, 0, c); U8V_DOT(5, 1);
        U8V_LOAD(7, 1, c); U8V_DOT(6, 0);
        U8V_LOAD(8, 0, c); U8V_DOT(7, 1);
        U8V_LOAD(9, 1, c); U8V_DOT(8, 0);
        U8V_LOAD(10, 0, c); U8V_DOT(9, 1);
        U8V_LOAD(11, 1, c); U8V_DOT(10, 0);
        U8V_LOAD(12, 0, c); U8V_DOT(11, 1);
        U8V_LOAD(13, 1, c); U8V_DOT(12, 0);
        U8V_LOAD(14, 0, c); U8V_DOT(13, 1);
        U8V_LOAD(15, 1, c); U8V_DOT(14, 0);
        { const int cn = c + 1 < 16 ? c + 1 : c; U8V_LOAD(0, 0, cn); }
        U8V_DOT(15, 1);
    }
#undef U8V_LOAD
#undef U8V_DOT
#pragma unroll
    for (int i = 0; i < 64; ++i) { const bool up = (j & 4) != 0; const int snd = up ? acc[i] : acc[i + 64], kp = up ? acc[i + 64] : acc[i]; acc[i] = kp + __shfl_xor(snd, 4); }
#pragma unroll
    for (int i = 0; i < 32; ++i) { const bool up = (j & 2) != 0; const int snd = up ? acc[i] : acc[i + 32], kp = up ? acc[i + 32] : acc[i]; acc[i] = kp + __shfl_xor(snd, 2); }
#pragma unroll
    for (int i = 0; i < 16; ++i) { const bool up = (j & 1) != 0; const int snd = up ? acc[i] : acc[i + 16], kp = up ? acc[i + 16] : acc[i]; acc[i] = kp + __shfl_xor(snd, 1); }
    const int k0 = ((j >> 2) & 1) * 64 + ((j >> 1) & 1) * 32 + (j & 1) * 16; const float hs = hqs[tok];
    const float* gp = gw + (size_t)tok * 128 + k0; const unsigned* ep = eidx + (size_t)tok * 128 + k0;
    LAS float* wp = (LAS float*)(eo + 64 * 128) + (wv * 8 + tl) * 128 + k0;
#pragma unroll
    for (int i = 0; i < 16; i += 4) { f4 g = *(const f4*)(gp + i); const u4 e4 = *(const u4*)(ep + i);
        g[0] *= gelu_exact((float)acc[i] * hs * USC[e4[0]]); g[1] *= gelu_exact((float)acc[i + 1] * hs * USC[e4[1]]); g[2] *= gelu_exact((float)acc[i + 2] * hs * USC[e4[2]]); g[3] *= gelu_exact((float)acc[i + 3] * hs * USC[e4[3]]);
        g[0] *= VSC[e4[0]]; g[1] *= VSC[e4[1]]; g[2] *= VSC[e4[2]]; g[3] *= VSC[e4[3]]; *(LAS f4*)(wp + i) = g; }
    __syncthreads();
}

__device__ __forceinline__ void p11_peer_v8(const unsigned char* V8, const float* gate2, const float* x1, float* out, LAS unsigned char* lds, int blk) {
    const int tid = threadIdx.x, wv = tid >> 6, lane = tid & 63, tl = lane >> 3, j = lane & 7;
    LAS unsigned* eo = (LAS unsigned*)lds; LAS float* wl = (LAS float*)(eo + 64 * 128);
    const int base = blk * 64;
    const int tok = base + wv * 8 + tl, b = tok / NT;
    const LAS unsigned* myeo = eo + (wv * 8 + tl) * 128; const LAS float* mywl = wl + (wv * 8 + tl) * 128;
    const __amdgpu_buffer_rsrc_t vrs = __builtin_amdgcn_make_buffer_rsrc((void*)V8, 0, 0x7fffffff, 0x00020000);
    constexpr int NBUF = 4;
    uint4 vb[NBUF][8];
#define V8_LOAD(B, g, cc) do { const int so_ = (cc) * (int)PEER8_SLAB; \
        _Pragma("unroll") for (int q = 0; q < 4; ++q) { vb[B][q] = __builtin_bit_cast(uint4, __builtin_amdgcn_raw_buffer_load_b128(vrs, (int)ofa[q] + j * 16, so_, 0)); vb[B][4 + q] = __builtin_bit_cast(uint4, __builtin_amdgcn_raw_buffer_load_b128(vrs, (int)ofb[q] + j * 16, so_, 0)); } \
        { const LAS unsigned* mo_ = myeo; asm volatile("" : "+v"(mo_)); ofa = *(const LAS u4*)(mo_ + ((((g) + 1) & 15) * 8)); ofb = *(const LAS u4*)(mo_ + ((((g) + 1) & 15) * 8) + 4); }     \
        asm volatile("" ::: "memory"); __builtin_amdgcn_sched_barrier(0); } while (0)
#define V8_FMA(B, g) do { const f4 wa = *(const LAS f4*)(mywl + (g) * 8), wb = *(const LAS f4*)(mywl + (g) * 8 + 4); \
        _Pragma("unroll") for (int q = 0; q < 8; ++q) { unsigned uu[4] = {vb[B][q].x, vb[B][q].y, vb[B][q].z, vb[B][q].w}; const float w = q < 4 ? wa[q & 3] : wb[q & 3]; \
            asm volatile("" : "+v"(uu[0]), "+v"(uu[1]), "+v"(uu[2]), "+v"(uu[3]));     \
            const f2v w2 = {w, w}; \
            _Pragma("unroll") for (int d = 0; d < 4; ++d) { acc[2 * d] = __builtin_elementwise_fma(w2, __builtin_amdgcn_cvt_pk_f32_fp8((int)uu[d], false), acc[2 * d]); acc[2 * d + 1] = __builtin_elementwise_fma(w2, __builtin_amdgcn_cvt_pk_f32_fp8((int)uu[d], true), acc[2 * d + 1]); } \
            asm volatile("" : "+v"(acc[0]), "+v"(acc[1]), "+v"(acc[2]), "+v"(acc[3]), "+v"(acc[4]), "+v"(acc[5]), "+v"(acc[6]), "+v"(acc[7])); } } while (0)
    u4 ofa = *(const LAS u4*)myeo, ofb = *(const LAS u4*)(myeo + 4);
#pragma unroll
    for (int g = 0; g < NBUF - 1; ++g) V8_LOAD(g, g, 0);
#pragma unroll 1
    for (int c = 0; c < 32; ++c) {
        f2v acc[8];
#pragma unroll
        for (int i = 0; i < 8; ++i) acc[i] = f2v{0.f, 0.f};
        const int col = c * 128 + j * 16; const float* xp = x1 + (size_t)tok * DM + col; const float* gp = gate2 + (size_t)b * NMOD + col;
        f4 xq[4], gq[4];
#pragma unroll
        for (int q = 0; q < 4; ++q) { xq[q] = *(const f4*)(xp + q * 4); gq[q] = *(const f4*)(gp + q * 4); }
#pragma unroll
        for (int g = 0; g < 16; ++g) {
            const int gn = g + NBUF - 1;
            if (gn < 16) V8_LOAD(gn % NBUF, gn, c); else { const int cn = c + 1 < 32 ? c + 1 : c; V8_LOAD(gn % NBUF, gn - 16, cn); }
            V8_FMA(g % NBUF, g);
        }
        float* op = out + (size_t)tok * DM + col;
#pragma unroll
        for (int q = 0; q < 4; ++q) { f4 xv = xq[q]; const f4 gv = gq[q];
            xv[0] += gv[0] * acc[q * 2][0]; xv[1] += gv[1] * acc[q * 2][1]; xv[2] += gv[2] * acc[q * 2 + 1][0]; xv[3] += gv[3] * acc[q * 2 + 1][1]; *(f4*)(op + q * 4) = xv; }
    }
    __syncthreads();
}

}
namespace {
constexpr size_t WS_H8 = WS_END_F;
constexpr size_t WS_HSC = WS_H8 + (size_t)NTOK * DM;
constexpr size_t WS_W8 = WS_HSC + 65536;
constexpr size_t WS_SB = WS_W8 + (size_t)PLD * DM;
constexpr size_t WS_END_G = WS_SB + 32768;
constexpr size_t CTL_AMAXW = 32768;

struct EpiBf16S {
    static constexpr bool PERM = true, AFTER_DRAIN = false;
    bf16_t* O; int ldc; const float* sa; const float* sb;
    __device__ __forceinline__ void operator()(const pg8::f32x4 (&acc)[2][2][4][2], const pg8::Unit& u, int wr, int wc, int fr, int fq) const {
        using pg8::f32x4; using pg8::HALF; using pg8::BM;
        const int row0 = u.pm * BM + wr * 64 + fr, col0 = u.pn * BM + wc * 32 + 8 * fq;
        f32x4 bv[2][2];
#pragma unroll
        for (int bj = 0; bj < 2; ++bj)
#pragma unroll
            for (int n = 0; n < 2; ++n) bv[bj][n] = *(const f32x4*)(sb + col0 + bj * HALF + 4 * n);
#pragma unroll
        for (int ai = 0; ai < 2; ++ai)
#pragma unroll
            for (int m = 0; m < 4; ++m) { const int row = row0 + ai * HALF + m * 16; const float s = sa[row]; bf16_t* rowp = O + (size_t)row * ldc + col0;
#pragma unroll
                for (int bj = 0; bj < 2; ++bj) { const f32x4 v0 = acc[ai][bj][m][0] * bv[bj][0] * s, v1 = acc[ai][bj][m][1] * bv[bj][1] * s;
                    pg8::u32x4 w; w.x = pg8::cvt_pk_bf16(v0[0], v0[1]); w.y = pg8::cvt_pk_bf16(v0[2], v0[3]); w.z = pg8::cvt_pk_bf16(v1[0], v1[1]); w.w = pg8::cvt_pk_bf16(v1[2], v1[3]);
                    *(pg8::u32x4*)(rowp + bj * HALF) = w; } }
    }
};

__device__ __forceinline__ void p1_norm_fp8(const float* x, const float* g, const float* part, const float* b_ada, float* mod_out, unsigned char* H8, float* SA,
                                            const bf16_t* WinT, const unsigned* amax, unsigned char* W8, float* SB, LAS unsigned char* lds, int blk, int nblk) {
    const int tid = threadIdx.x, lane = tid & 63, wv = tid >> 6; const int b = (blk * 64) / NT;
    LAS float* av = (LAS float*)lds; LAS float* sv = av + DM;
    for (int i = tid; i < DM; i += NTHR) { av[i] = g[i] * (1.0f + mod_reduce(part, b_ada, b, 1 * DM + i)); sv[i] = mod_reduce(part, b_ada, b, 0 * DM + i); }
    for (int o = blk * 768 + tid; o < blk * 768 + 768; o += NTHR) mod_out[o] = mod_reduce(part, b_ada, o / NMOD, o % NMOD);
    for (int n = blk * NWAVES + wv; n < PLD; n += nblk * NWAVES) {
        const float am = __uint_as_float(amax[n]); const float inv = am > 0.f ? 448.0f / am : 1.0f;
        if (lane == 0) SB[n] = am > 0.f ? am * (1.0f / 448.0f) : 1.0f;
        const bf16_t* wr = WinT + (size_t)n * DM + lane * 8; unsigned char* wo = W8 + (size_t)n * DM + lane * 8;
        uint4 u[8];
#pragma unroll
        for (int i = 0; i < 8; ++i) u[i] = *(const uint4*)(wr + i * 512);
#pragma unroll
        for (int i = 0; i < 8; ++i) { uint2 o;
            o.x = pk4_fp8(__uint_as_float(u[i].x << 16) * inv, __uint_as_float(u[i].x & 0xffff0000u) * inv, __uint_as_float(u[i].y << 16) * inv, __uint_as_float(u[i].y & 0xffff0000u) * inv);
            o.y = pk4_fp8(__uint_as_float(u[i].z << 16) * inv, __uint_as_float(u[i].z & 0xffff0000u) * inv, __uint_as_float(u[i].w << 16) * inv, __uint_as_float(u[i].w & 0xffff0000u) * inv);
            *(uint2*)(wo + i * 512) = o; }
    }
    __syncthreads();
#pragma unroll 1
    for (int tt = wv; tt < 64; tt += NWAVES) {
        const int tok = blk * 64 + tt; const float* xr = x + (size_t)tok * DM;
        float4 v[16]; float ss = 0.f;
#pragma unroll
        for (int i = 0; i < 16; ++i) { v[i] = *(const float4*)(xr + i * 256 + lane * 4); ss += v[i].x * v[i].x + v[i].y * v[i].y + v[i].z * v[i].z + v[i].w * v[i].w; }
        ss = wave_sum(ss); const float rstd = rsqrtf(ss * (1.0f / DM) + 1e-6f);
        float m = 0.f;
#pragma unroll
        for (int i = 0; i < 16; ++i) { const int col = i * 256 + lane * 4; const f4 a = *(const LAS f4*)(av + col), s = *(const LAS f4*)(sv + col);
            v[i].x = v[i].x * rstd * a[0] + s[0]; v[i].y = v[i].y * rstd * a[1] + s[1]; v[i].z = v[i].z * rstd * a[2] + s[2]; v[i].w = v[i].w * rstd * a[3] + s[3];
            m = fmaxf(m, fmaxf(fmaxf(fabsf(v[i].x), fabsf(v[i].y)), fmaxf(fabsf(v[i].z), fabsf(v[i].w)))); }
        m = wave_max(m); const float inv = m > 0.f ? 448.0f / m : 1.0f;
        if (lane == 0) SA[tok] = m > 0.f ? m * (1.0f / 448.0f) : 1.0f;
#pragma unroll
        for (int i = 0; i < 16; ++i) *(unsigned*)(H8 + (size_t)tok * DM + i * 256 + lane * 4) = pk4_fp8(v[i].x * inv, v[i].y * inv, v[i].z * inv, v[i].w * inv);
    }
    __syncthreads();
}


}
namespace {
constexpr size_t WS_MIX8 = WS_END_G;
constexpr size_t WS_SAM = WS_MIX8 + (size_t)NTOK * DM;
constexpr size_t WS_WO8 = WS_SAM + 65536;
constexpr size_t WS_SBO = WS_WO8 + (size_t)DM * DM;
constexpr size_t WS_END_H = WS_SBO + 16384;
constexpr size_t WS_HQ = WS_END_H;
constexpr size_t WS_HQS = WS_HQ + (size_t)NTOK * DM;
constexpr size_t WS_END_I = WS_HQS + 65536;
constexpr size_t CTL_AMAXO = 16384;

struct EpiResidS {
    static constexpr bool PERM = false, AFTER_DRAIN = false;
    const float* X; float* C; int ldc; const float* gate; const float* sa; const float* sb;
    __device__ __forceinline__ void operator()(const pg8::f32x4 (&acc)[2][2][4][2], const pg8::Unit& u, int wr, int wc, int fr, int fq) const {
        using pg8::f32x4; using pg8::HALF; using pg8::BM;
        const int row0 = u.pm * BM + wr * 64 + fr, col0 = u.pn * BM + wc * 32 + 4 * fq;
        const float* gp = gate + (size_t)(u.pm >> 3) * NMOD;
        f32x4 gv[2][2];
#pragma unroll
        for (int bj = 0; bj < 2; ++bj)
#pragma unroll
            for (int n = 0; n < 2; ++n) gv[bj][n] = *(const f32x4*)(gp + col0 + bj * HALF + n * 16) * *(const f32x4*)(sb + col0 + bj * HALF + n * 16);
#pragma unroll
        for (int ai = 0; ai < 2; ++ai)
#pragma unroll
            for (int m = 0; m < 4; ++m) { const int row = row0 + ai * HALF + m * 16; const float s = sa[row]; const size_t off = (size_t)row * ldc + col0;
#pragma unroll
                for (int bj = 0; bj < 2; ++bj)
#pragma unroll
                    for (int n = 0; n < 2; ++n) { const f32x4 xv = *(const f32x4*)(X + off + bj * HALF + n * 16); *(f32x4*)(C + off + bj * HALF + n * 16) = xv + gv[bj][n] * acc[ai][bj][m][n] * s; }
                asm volatile("" ::: "memory"); }
    }
};

template <bool ROWMAX>
__device__ __forceinline__ void rows_to_fp8(const bf16_t* src, int nrows, const unsigned* amax, unsigned char* dst, float* scale, int blk, int nblk) {
    const int tid = threadIdx.x, lane = tid & 63, wv = tid >> 6, step = nblk * NWAVES;
    int r = blk * NWAVES + wv; if (r >= nrows) return;
    uint4 u[8];
    { const bf16_t* sp = src + (size_t)r * DM + lane * 8;
#pragma unroll
      for (int i = 0; i < 8; ++i) u[i] = *(const uint4*)(sp + i * 512); }
#pragma unroll 1
    for (; r < nrows; r += step) {
        const int rn = r + step < nrows ? r + step : r;
        uint4 un[8];
        { const bf16_t* sp = src + (size_t)rn * DM + lane * 8;
#pragma unroll
          for (int i = 0; i < 8; ++i) un[i] = *(const uint4*)(sp + i * 512); }
        unsigned char* dp = dst + (size_t)r * DM + lane * 8;
        float am;
        if (ROWMAX) { float m = 0.f;
#pragma unroll
            for (int i = 0; i < 8; ++i) { const unsigned w4[4] = {u[i].x, u[i].y, u[i].z, u[i].w};
#pragma unroll
                for (int e = 0; e < 4; ++e) m = fmaxf(m, fmaxf(fabsf(__uint_as_float(w4[e] << 16)), fabsf(__uint_as_float(w4[e] & 0xffff0000u)))); }
            am = wave_max(m); } else am = __uint_as_float(amax[r]);
        const float inv = am > 0.f ? 448.0f / am : 1.0f;
        if (lane == 0) scale[r] = am > 0.f ? am * (1.0f / 448.0f) : 1.0f;
#pragma unroll
        for (int i = 0; i < 8; ++i) { uint2 o;
            o.x = pk4_fp8(__uint_as_float(u[i].x << 16) * inv, __uint_as_float(u[i].x & 0xffff0000u) * inv, __uint_as_float(u[i].y << 16) * inv, __uint_as_float(u[i].y & 0xffff0000u) * inv);
            o.y = pk4_fp8(__uint_as_float(u[i].z << 16) * inv, __uint_as_float(u[i].z & 0xffff0000u) * inv, __uint_as_float(u[i].w << 16) * inv, __uint_as_float(u[i].w & 0xffff0000u) * inv);
            *(uint2*)(dp + i * 512) = o; }
#pragma unroll
        for (int i = 0; i < 8; ++i) u[i] = un[i];
    }
}
}
__global__ void __launch_bounds__(NTHR, 2) fwd(Args args) {
    extern __shared__ __attribute__((aligned(16))) unsigned char lds_raw[];
    LAS unsigned char* lds = (LAS unsigned char*)lds_raw;
    const int tid = threadIdx.x, blk = blockIdx.x, nblk = gridDim.x;
    unsigned char* ws = args.ws;
    const float* x = args.in[0]; const float* c = args.in[1]; const float* w_ada = args.in[2]; const float* b_ada = args.in[3];
    const float* norm1_g = args.in[4]; const float* norm2_g = args.in[5]; const float* w_in = args.in[6]; const float* w_out = args.in[7];
    const float* w_pool = args.in[8]; const float* pool_scale = args.in[9]; const float* q_norm_g = args.in[10]; const float* k_norm_g = args.in[11];
    const float* cmp_pe = args.in[12]; const float* cmp_w1 = args.in[13]; const float* cmp_w2 = args.in[14];
    const float* w_pq = args.in[15]; const float* peer_keys = args.in[16]; const float* peer_u = args.in[17]; const float* peer_v = args.in[18];
    float* mod = (float*)(ws + WS_MOD);
    bf16_t* WinT = (bf16_t*)(ws + WS_WINT); bf16_t* WoutT = (bf16_t*)(ws + WS_WOUTT); bf16_t* WpqT = (bf16_t*)(ws + WS_WPQT);
    bf16_t* H = (bf16_t*)(ws + WS_H); bf16_t* PROJ = (bf16_t*)(ws + WS_PROJ); bf16_t* MIX = (bf16_t*)(ws + WS_MIX); bf16_t* QP = (bf16_t*)(ws + WS_QP);
    bf16_t* UB = (bf16_t*)(ws + WS_UB); bf16_t* VB = (bf16_t*)(ws + WS_VB); bf16_t* KEYSB = (bf16_t*)(ws + WS_KEYSB); unsigned* EIDX = (unsigned*)(ws + WS_EIDX); float* GW = (float*)(ws + WS_GW);
    float* ROPE = (float*)(ws + WS_ROPE); bf16_t* WPT = (bf16_t*)(ws + WS_WPT); bf16_t* W1T = (bf16_t*)(ws + WS_W1T); bf16_t* W2T = (bf16_t*)(ws + WS_W2T); float* PEB = (float*)(ws + WS_PEB);
    bf16_t* KSEL = (bf16_t*)(ws + WS_KSEL); bf16_t* KWIN = (bf16_t*)(ws + WS_KWIN); bf16_t* CMPK = (bf16_t*)(ws + WS_CMPK); bf16_t* CMPV = (bf16_t*)(ws + WS_CMPV);
    bf16_t* OC = (bf16_t*)(ws + WS_OC); unsigned* SELM = (unsigned*)(ws + WS_SELM);
    volatile LAS unsigned* xbw = (volatile LAS unsigned*)(lds + LDS_XBW);
    if (tid < 4) xbw[tid] = 0u;
    __syncthreads();
    const int lo = args.ph_lo, hi = args.ph_hi;
    XcdBarrier bar = xcd_barrier_post((unsigned*)(ws + WS_CTL) + args.li * XCD_BAR_WORDS, xbw);
#define IN(k) (lo <= (k) && (k) < hi)
#ifndef MK_REP_MASK
#define MK_REP_MASK 0
#endif
#define REP(k) ((MK_REP_MASK >> (k)) & 1)
#define SEAM(k) do { if (IN(k) && IN((k) + 1)) xcd_barrier(bar); } while (0)

    if (IN(0)) {
#pragma unroll 1
        for (int rp = 0; rp <= REP(0); ++rp) {
        p0_mod(c, w_ada, (float*)(ws + WS_PART), lds, blk);
        p0_transpose(w_in, DM, INW, PLD, WinT, lds, blk, nblk, (unsigned*)(ws + WS_CTL + CTL_AMAXW));
#pragma unroll 1
        for (int gi = 0; gi < 4; ++gi) p0_frag(w_pool + (size_t)gi * 65536, 1, 256, 8, 16, WPT + (size_t)gi * 65536, blk, nblk);
#pragma unroll 1
        for (int kv = 0; kv < 2; ++kv) { p0_frag(cmp_w1 + (size_t)kv * 4096 * 256, 1, 256, 8, 256, W1T + (size_t)kv * 256 * 4096, blk, nblk);
            p0_transpose(cmp_w2 + (size_t)kv * 256 * 128, 256, 128, 128, W2T + (size_t)kv * 128 * 256, lds, blk, nblk); }
#pragma unroll 1
        for (int li = 0; li < 16; ++li) p0_frag(peer_keys + (size_t)li * 16384, 128, 1, 4, 8, KEYSB + (size_t)li * 16384, blk, nblk);
        p0_rope(ROPE, blk, nblk);
        p0_peb(cmp_pe, cmp_w1, PEB, lds, blk);
            if (rp < REP(0)) xcd_barrier(bar); }
    }
    SEAM(0);
    if (IN(1)) {
#pragma unroll 1
        for (int rp = 0; rp <= REP(1); ++rp) { p1_norm_fp8(x, norm1_g, (const float*)(ws + WS_PART), b_ada, mod, ws + WS_H8, (float*)(ws + WS_HSC), WinT, (const unsigned*)(ws + WS_CTL + CTL_AMAXW), ws + WS_W8, (float*)(ws + WS_SB), lds, blk, nblk);
            if (rp < REP(1)) xcd_barrier(bar); }
    }
    SEAM(1);
    if (IN(2)) {
#pragma unroll 1
        for (int rp = 0; rp <= REP(2); ++rp) {
        pg8::Gemm g{(const bf16_t*)(ws + WS_H8), (const bf16_t*)(ws + WS_W8), NTOK, PLD, DM / 2}; pg8::StaticOrder S; S.init(NTOK, PLD, nblk, blk);
        EpiBf16S E{PROJ, PLD, (const float*)(ws + WS_HSC), (const float*)(ws + WS_SB)};
        pg8::gemm_phase<EpiBf16S, pg8::StaticOrder, false, true>(lds, g, S, E, nullptr);
        if (blk >= 64 && nblk == 256) { const int tb = blk - 64, tn = nblk - 64;
            p0_peer_cvt_i4(peer_u, (unsigned char*)UB, (float*)(ws + WS_USC), tb, tn);
            p0_peer_cvt8(peer_v, (unsigned char*)VB, (float*)(ws + WS_VSC), tb, tn);
            p0_transpose(w_out, DM, DM, DM, WoutT, lds, tb, tn, (unsigned*)(ws + WS_CTL + CTL_AMAXO));
            p0_transpose(w_pq, DM, 2048, 2048, WpqT, lds, tb, tn); }
            if (rp < REP(2)) xcd_barrier(bar); }
    }
    SEAM(2);
    if (IN(3)) {
#pragma unroll 1
        for (int rp = 0; rp <= REP(3); ++rp) {
        for (int r2 = 0; r2 <= REP(12); ++r2) p3_knorm(PROJ, k_norm_g, ROPE, KSEL, KWIN, blk);
        for (int r2 = 0; r2 <= REP(13); ++r2) p3_compress(PROJ, W1T, W2T, PEB, k_norm_g, CMPK, CMPV, lds, blk, nblk);
        for (int r2 = 0; r2 <= REP(14); ++r2) p3_pool(PROJ, WPT, pool_scale, MIX, lds, blk, nblk);
            if (rp < REP(3)) xcd_barrier(bar); }
    }
    SEAM(3);
    if (IN(4)) {
#pragma unroll 1
        for (int rp = 0; rp <= REP(4); ++rp) { p4a_cmp(PROJ, CMPK, CMPV, q_norm_g, OC, SELM, lds, blk, nblk);
            if (rp < REP(4)) xcd_barrier(bar); }
    }
    SEAM(4);
    if (IN(5)) {
#pragma unroll 1
        for (int rp = 0; rp <= REP(5); ++rp) { p4b_attn(PROJ, KSEL, KWIN, SELM, OC, ROPE, q_norm_g, MIX, lds, blk, nblk);
            if (rp < REP(5)) xcd_barrier(bar); }
    }
    SEAM(5);
    if (IN(6)) {
#pragma unroll 1
        for (int rp = 0; rp <= REP(6); ++rp) {
        rows_to_fp8<true>(MIX, NTOK, nullptr, ws + WS_MIX8, (float*)(ws + WS_SAM), blk, nblk);
        rows_to_fp8<false>(WoutT, DM, (const unsigned*)(ws + WS_CTL + CTL_AMAXO), ws + WS_WO8, (float*)(ws + WS_SBO), blk, nblk);
        xcd_barrier(bar);
        pg8::Gemm g{(const bf16_t*)(ws + WS_MIX8), (const bf16_t*)(ws + WS_WO8), NTOK, DM, DM / 2}; pg8::StaticOrder S; S.init(NTOK, DM, nblk, blk);
        EpiResidS E{x, args.out, DM, mod + 2 * DM, (const float*)(ws + WS_SAM), (const float*)(ws + WS_SBO)};
        pg8::gemm_phase<EpiResidS, pg8::StaticOrder, false, true>(lds, g, S, E, nullptr);
            if (rp < REP(6)) xcd_barrier(bar); }
    }
    SEAM(6);
    if (IN(7)) {
#pragma unroll 1
        for (int rp = 0; rp <= REP(7); ++rp) { p_norm_mod<false>(args.out, norm2_g, mod, nullptr, nullptr, nullptr, 3 * DM, 4 * DM, H, lds, blk, ws + WS_HQ, (float*)(ws + WS_HQS));
            if (rp < REP(7)) xcd_barrier(bar); }
    }
    SEAM(7);
    if (IN(8)) {
#pragma unroll 1
        for (int rp = 0; rp <= REP(8); ++rp) {
        pg8::Gemm g{H, WpqT, NTOK, 2048, DM}; pg8::StaticOrder S; S.init(NTOK, 2048, nblk, blk);
        pg8::EpiBf16<0> E{QP, 2048, nullptr, 0, 0};
        pg8::gemm_phase<pg8::EpiBf16<0>, pg8::StaticOrder, false>(lds, g, S, E, nullptr);
            if (rp < REP(8)) xcd_barrier(bar); }
    }
    SEAM(8);
    if (IN(9)) {
#pragma unroll 1
        for (int rp = 0; rp <= REP(9); ++rp) { p8_topk(QP, KEYSB, EIDX, GW, lds, blk, nblk);
            asm volatile("s_waitcnt vmcnt(0)" ::: "memory"); __syncthreads();
            p10_peer_u8v(ws + WS_HQ, (const float*)(ws + WS_HQS), (const unsigned char*)UB, (const float*)(ws + WS_USC), (const float*)(ws + WS_VSC), EIDX, GW, lds, blk);
            p11_peer_v8((const unsigned char*)VB, mod + 5 * DM, args.out, args.out, lds, blk);
            if (rp < REP(9)) xcd_barrier(bar); }
    }
#undef IN
#undef SEAM
}

constexpr int NPHASES = 12;
#ifndef MK_PROBE_NSA
#define MK_PROBE_NSA 0
#endif
#if MK_PROBE_NSA
__global__ void k_probe_ratio(const float* mixf, const bf16_t* mix, float* acc) {
    size_t i = (size_t)blockIdx.x * blockDim.x + threadIdx.x; int c = (int)(i & 4095); float d = 0.f, n = 0.f;
    if (c >= 1024) { n = mixf[i]; d = bf2f(mix[i]) - n; }
    float sd = wave_sum(d * d), sn = wave_sum(n * n);
    if ((threadIdx.x & 63) == 0) { atomicAdd(acc, sd); atomicAdd(acc + 1, sn); }
}
__global__ void k_probe_inject(const float* acc, const float* x, float* out) {
    size_t i = (size_t)blockIdx.x * blockDim.x + threadIdx.x; const float eps = sqrtf(acc[0] / acc[1]);
    out[i] += 100.f * eps * x[i];
}
#endif
#ifndef MK_PER_PHASE
#define MK_PER_PHASE 0
#endif

extern "C" void kernel_launch(void* const* d_in, const int* in_sizes, int n_in, void* d_out, int out_size, void* d_ws, size_t ws_size, hipStream_t stream) {
    static int ready = 0;
    if (!ready) {
        if (hipFuncSetAttribute((const void*)fwd, hipFuncAttributeMaxDynamicSharedMemorySize, LDS_BYTES) != hipSuccess) { fprintf(stderr, "kernel_launch: hipFuncSetAttribute failed\n"); return; }
        if (ws_size < WS_END_I) { fprintf(stderr, "kernel_launch: workspace too small (%zu < %zu)\n", ws_size, (size_t)WS_END_I); return; }
        ready = 1;
    }
    (void)in_sizes; (void)n_in; (void)out_size;
    Args a{};
    for (int i = 0; i < 19; ++i) a.in[i] = (const float*)d_in[i];
    a.out = (float*)d_out; a.ws = (unsigned char*)d_ws; a.ph_lo = 0; a.ph_hi = NPHASES; a.li = 0; a.pad = 0;
    (void)hipMemsetAsync((char*)d_ws + WS_CTL, 0, 65536, stream);
#if MK_PER_PHASE
    for (int p = 0; p < NPHASES; ++p) { a.ph_lo = p; a.ph_hi = p + 1; hipLaunchKernelGGL(fwd, dim3(256), dim3(NTHR), LDS_BYTES, stream, a); }
#else
    hipLaunchKernelGGL(fwd, dim3(256), dim3(NTHR), LDS_BYTES, stream, a);
#endif

#if MK_PROBE_NSA
    {
        char* wsb = (char*)d_ws; size_t off = WS_END_I;
        auto take = [&](size_t bytes) { char* p = wsb + off; off += (bytes + 255) & ~(size_t)255; return p; };
        float* mixf = (float*)take((size_t)NTOK * DM * 4); float* dpool = (float*)take((size_t)NTOK * 1024 * 4);
        float* ksel = (float*)take((size_t)NTOK * 512 * 4); float* kwin = (float*)take((size_t)NTOK * 512 * 4);
        float* cmpb = (float*)take((size_t)2 * NB * 128 * 4 * 128 * 4); unsigned* selmask = (unsigned*)take((size_t)NTOK * 4 * 4);
        const bf16_t* PROJ = (const bf16_t*)(wsb + WS_PROJ); const bf16_t* MIX = (const bf16_t*)(wsb + WS_MIX);
        const float* k_norm_g = (const float*)d_in[11]; const float* q_norm_g = (const float*)d_in[10]; const float* w_pool = (const float*)d_in[8]; const float* pool_scale = (const float*)d_in[9];
        k_pool_d<<<NTOK * 1024 / 256, 256, 0, stream>>>(PROJ, dpool);
        for (int gi = 0; gi < 4; ++gi) k_gemm<<<dim3(4, NTOK / 64), 256, 0, stream>>>(dpool + gi * 256, 1024, w_pool + (size_t)gi * 65536, 256, mixf + gi * 256, DM, NTOK, 256, 256);
        k_pool_scale<<<NTOK * 1024 / 256, 256, 0, stream>>>(mixf, pool_scale);
        k_knorm_rope<<<NTOK, 256, 0, stream>>>(PROJ, k_norm_g, ksel, kwin);
        k_cmp<<<2 * NB * NCMP * 4, 256, 0, stream>>>(PROJ, (const float*)d_in[12], (const float*)d_in[13], (const float*)d_in[14], k_norm_g, cmpb);
        k_attn_cmp<<<NTOK * 4, 128, 0, stream>>>(PROJ, q_norm_g, cmpb, mixf, selmask);
        k_attn_sw<<<NTOK * 4, 256, 0, stream>>>(PROJ, q_norm_g, ksel, kwin, MK_PROBE_NSA == 2 ? selmask : (const unsigned*)(wsb + WS_SELM), mixf);
        float* pacc = (float*)take(256); (void)hipMemsetAsync(pacc, 0, 256, stream);
        k_probe_ratio<<<(unsigned)((size_t)NTOK * DM / 256), 256, 0, stream>>>(mixf, MIX, pacc);
        k_probe_inject<<<(unsigned)((size_t)NTOK * DM / 256), 256, 0, stream>>>(pacc, (const float*)d_in[0], (float*)d_out);
    }
#endif
}
```

```cpp
#include <hip/hip_runtime.h>
#include <math.h>
#include <stdint.h>
#include <stdio.h>

#define LAS __attribute__((address_space(3)))
typedef unsigned short bf16_t;
typedef float f4 __attribute__((ext_vector_type(4)));
namespace {
constexpr int NB = 8, NT = 2048, DM = 4096, NTOK = NB * NT, INW = 7240, PLD = 7424;
constexpr int QOFF = 1024, KVOFF = 4096, GOFF = 7168, NCMP = 127, NMOD = 6 * DM;
constexpr float SCALE = 0.08838834764831845f;
constexpr int NTHR = 512, NWAVES = 8;
constexpr int LDS_BYTES = 147456;
constexpr int LDS_XBW = LDS_BYTES - 64;

__device__ __forceinline__ float bf2f(bf16_t v) { return __uint_as_float(((unsigned)v) << 16); }
__device__ __forceinline__ bf16_t f2bf(float f) { unsigned u = __float_as_uint(f); u += 0x7FFFu + ((u >> 16) & 1u); return (bf16_t)(u >> 16); }
__device__ __forceinline__ unsigned pk_bf16(float lo, float hi) { unsigned r; asm volatile("v_cvt_pk_bf16_f32 %0, %1, %2" : "=v"(r) : "v"(lo), "v"(hi)); return r; }
__device__ __forceinline__ float wave_sum(float v) {
#pragma unroll
    for (int o = 32; o >= 1; o >>= 1) v += __shfl_xor(v, o);
    return v;
}
__device__ __forceinline__ float wave_max(float v) {
#pragma unroll
    for (int o = 32; o >= 1; o >>= 1) v = fmaxf(v, __shfl_xor(v, o));
    return v;
}
__device__ __forceinline__ float gelu_exact(float x) { return 0.5f * x * (1.0f + erff(x * 0.70710678118654752f)); }
}
namespace pg8 {
#define PG8_LAS __attribute__((address_space(3)))
typedef unsigned short bf16_t;
typedef short bf16x8 __attribute__((ext_vector_type(8)));
typedef float f32x4 __attribute__((ext_vector_type(4)));
typedef unsigned u32x4 __attribute__((ext_vector_type(4)));
typedef int pg8_i4 __attribute__((ext_vector_type(4)));
typedef int pg8_i8 __attribute__((ext_vector_type(8)));
constexpr int BM = 256, BK = 64, HALF = 128, HTB = HALF * BK * 2  , STAGE_BYTES = 8 * HTB, NXCD = 8, WGM = 8;

__host__ __device__ __forceinline__ int lds_byte(int r, int c) { const int st = (r >> 4) * 2 + (c >> 5), rr = r & 15, cc = c & 31, ob = rr * 64 + cc * 2; return st * 1024 + (ob ^ (((ob >> 9) & 1) << 5)); }
__host__ __device__ __forceinline__ void stage_rc(int b, int& R, int& C) { const int st = b / 1024, sb = b % 1024, swz = sb ^ (((sb >> 9) & 1) << 5); R = (st >> 1) * 16 + swz / 64; C = (st & 1) * 32 + (swz % 64) / 2; }
__host__ __device__ __forceinline__ int perm32(int rho) { const int n = rho >> 4, i = rho & 15; return 8 * (i >> 2) + 4 * n + (i & 3); }

struct Unit { int pm, pn; };
struct Gemm { const bf16_t* A; const bf16_t* Bt; int M, N, K; };

struct StaticOrder {
    int nM, nN, nwg, G, c;
    __host__ __device__ void init(int M, int N, int G_, int c_) { nM = M / BM; nN = N / BM; nwg = nM * nN; G = G_; c = c_; }
    __host__ __device__ bool next(int i, Unit& u) const {
        const long L = (long)i * G + c; if (L >= nwg) return false;
        int wgid = (int)L; { const int q = nwg / NXCD, r = nwg % NXCD, xcd = wgid % NXCD, off = wgid / NXCD; wgid = (xcd < r ? xcd * (q + 1) : r * (q + 1) + (xcd - r) * q) + off; }
        const int nig = WGM * nN, gid = wgid / nig, fm = gid * WGM, gsz = (nM - fm) < WGM ? (nM - fm) : WGM;
        u.pm = fm + ((wgid % nig) % gsz); u.pn = (wgid % nig) / gsz; return true;
    }
    __device__ __forceinline__ void a_ready(const Unit&) const {}
    __device__ __forceinline__ void done(const Unit&) const {}
};
__device__ __forceinline__ unsigned cvt_pk_bf16(float lo, float hi) { unsigned r; asm volatile("v_cvt_pk_bf16_f32 %0, %1, %2" : "=v"(r) : "v"(lo), "v"(hi)); return r; }
typedef float f32x2 __attribute__((ext_vector_type(2)));
__device__ __forceinline__ f32x2 gelu_pk(f32x2 v) {
    const f32x2 av = __builtin_elementwise_abs(v), d = av * 0.2316418882f + 1.0f;
    f32x2 t; t.x = __builtin_amdgcn_rcpf(d.x); t.y = __builtin_amdgcn_rcpf(d.y);
    f32x2 q = t * 0.5307027145f + (-0.7265760135f); q = q * t + 0.7107068705f; q = q * t + (-0.142248368f); q = q * t + 0.127414796f; q = q * t;
    const f32x2 s = (v * v) * (-0.72134752044f);
    f32x2 e; e.x = __builtin_amdgcn_exp2f(s.x); e.y = __builtin_amdgcn_exp2f(s.y);
    const f32x2 m = v * (q * e), r = v - m;
    f32x2 o; o.x = v.x < 0.f ? m.x : r.x; o.y = v.y < 0.f ? m.y : r.y; return o;
}

template <int ACT  > struct EpiBf16 {
    static constexpr bool PERM = true, AFTER_DRAIN = false;
    bf16_t* O; int ldc; const float* bias; int split_cols; size_t split_stride;
    __device__ __forceinline__ void operator()(const f32x4 (&acc)[2][2][4][2], const Unit& u, int wr, int wc, int fr, int fq) const {
        const int row0 = u.pm * BM + wr * 64 + fr; int colt = u.pn * BM; bf16_t* base = O;
        if (split_cols) { const int t = colt / split_cols; base += (size_t)t * split_stride; colt -= t * split_cols; }
        const int col0 = colt + wc * 32 + 8 * fq, bcol0 = u.pn * BM + wc * 32 + 8 * fq;
        f32x4 bv[2][2];
#pragma unroll
        for (int bj = 0; bj < 2; ++bj)
#pragma unroll
            for (int n = 0; n < 2; ++n) bv[bj][n] = bias ? *(const f32x4*)(bias + bcol0 + bj * HALF + 4 * n) : (f32x4){0.f, 0.f, 0.f, 0.f};
#pragma unroll
        for (int ai = 0; ai < 2; ++ai)
#pragma unroll
            for (int m = 0; m < 4; ++m) { bf16_t* rowp = base + (size_t)(row0 + ai * HALF + m * 16) * ldc + col0;
#pragma unroll
                for (int bj = 0; bj < 2; ++bj) { f32x4 v0 = acc[ai][bj][m][0] + bv[bj][0], v1 = acc[ai][bj][m][1] + bv[bj][1];
                    if (ACT == 1) { f32x2 a = gelu_pk((f32x2){v0[0], v0[1]}), b = gelu_pk((f32x2){v0[2], v0[3]}), c = gelu_pk((f32x2){v1[0], v1[1]}), d = gelu_pk((f32x2){v1[2], v1[3]});
                        v0 = (f32x4){a.x, a.y, b.x, b.y}; v1 = (f32x4){c.x, c.y, d.x, d.y}; }
                    if (ACT == 2) {
#pragma unroll
                        for (int j = 0; j < 4; ++j) { v0[j] = 0.5f * v0[j] * (1.0f + erff(v0[j] * 0.70710678f)); v1[j] = 0.5f * v1[j] * (1.0f + erff(v1[j] * 0.70710678f)); } }
                    u32x4 w; w.x = cvt_pk_bf16(v0[0], v0[1]); w.y = cvt_pk_bf16(v0[2], v0[3]); w.z = cvt_pk_bf16(v1[0], v1[1]); w.w = cvt_pk_bf16(v1[2], v1[3]);
                    *(u32x4*)(rowp + bj * HALF) = w; } }
    }
};
template <class Epi, class Sched, bool STAMP = false, bool FP8 = false, int NBF = 0>
__device__ __forceinline__ void gemm_phase(PG8_LAS unsigned char* lds, const Gemm g, const Sched& S, const Epi& E, unsigned long long* stamps) {
    const int tid = threadIdx.x, wid = __builtin_amdgcn_readfirstlane(tid >> 6), lane = tid & 63, wr = wid >> 2, wc = wid & 3, fr = lane & 15, fq = lane >> 4;
    const int K = g.K, nt = K / BK;
    int ts_lo = 0, ts_hi = 0, nts = 0; const unsigned long long rt_entry = STAMP ? (unsigned long long)wall_clock64() : 0ull;
#define PG8_STAMP() do { if (STAMP && wid == 0 && nts < 64) { const unsigned long long _c = (unsigned long long)clock64(); \
        ts_lo = (lane == nts) ? (int)(unsigned)_c : ts_lo; ts_hi = (lane == nts) ? (int)(unsigned)(_c >> 32) : ts_hi; ++nts; } } while (0)
    PG8_STAMP();
    unsigned voffA[2], voffB[2];
#pragma unroll
    for (int i = 0; i < 2; ++i) { int R, C; stage_rc(tid * 16 + i * 8192, R, C); const int Rb = Epi::PERM ? ((R & ~31) + perm32(R & 31)) : R;
        voffA[i] = (unsigned)(R * K + C) * 2u; voffB[i] = (unsigned)(Rb * K + C) * 2u; }
    const size_t kstep = (size_t)(BK * 2);
    const size_t hstep = (size_t)HALF * K * 2;
    const size_t tstep = 2 * hstep;
    const unsigned ldsw = (unsigned)wid * 1024u;
    const int aoff = lds_byte(wr * 64 + fr, fq * 8), boff = lds_byte(wc * 32 + fr, fq * 8);
#define PG8_SA(b, h) (((b) * 2 + (h)) * HTB)
#define PG8_SB(b, h) ((4 + (b) * 2 + (h)) * HTB)
#define PG8_STAGE(bufoff, gbase, voff) do { _Pragma("unroll") for (int _i = 0; _i < 2; ++_i) \
        __builtin_amdgcn_global_load_lds((const unsigned*)((const char*)(gbase) + (voff)[_i]), (PG8_LAS unsigned*)(lds + (bufoff) + ldsw + _i * 8192), 16, 0, 0); } while (0)
#define PG8_LDA(F, dst, b, h) do { _Pragma("unroll") for (int m = 0; m < 4; ++m) { if constexpr (F) { dst##8[m] = PG8_CAT(*(const PG8_LAS bf16x8*)(lds + PG8_SA(b, h) + aoff + m * 2048), *(const PG8_LAS bf16x8*)(lds + PG8_SA(b, h) + aoff + m * 2048 + 1024)); } \
        else { _Pragma("unroll") for (int k = 0; k < 2; ++k) dst[m][k] = *(const PG8_LAS bf16x8*)(lds + PG8_SA(b, h) + aoff + m * 2048 + k * 1024); } } } while (0)
#define PG8_LDB(F, dst, b, h) do { _Pragma("unroll") for (int n = 0; n < 2; ++n) { if constexpr (F) { dst##8[n] = PG8_CAT(*(const PG8_LAS bf16x8*)(lds + PG8_SB(b, h) + boff + n * 2048), *(const PG8_LAS bf16x8*)(lds + PG8_SB(b, h) + boff + n * 2048 + 1024)); } \
        else { _Pragma("unroll") for (int k = 0; k < 2; ++k) dst[n][k] = *(const PG8_LAS bf16x8*)(lds + PG8_SB(b, h) + boff + n * 2048 + k * 1024); } } } while (0)
#define PG8_CAT(x, y) __builtin_shufflevector(__builtin_bit_cast(pg8_i4, x), __builtin_bit_cast(pg8_i4, y), 0, 1, 2, 3, 4, 5, 6, 7)
#define PG8_MMA(F, ai, bj, At, Bt) do { __builtin_amdgcn_s_setprio(1); _Pragma("unroll") for (int m = 0; m < 4; ++m) _Pragma("unroll") for (int n = 0; n < 2; ++n) { \
        if constexpr (F) { asm("v_mfma_scale_f32_16x16x128_f8f6f4 %0, %1, %2, %0, %3, %3 op_sel_hi:[0,0,0]" : "+v"(acc[ai][bj][m][n]) : "v"(Bt##8[n]), "v"(At##8[m]), "v"(sc127)); } \
        else { _Pragma("unroll") for (int k = 0; k < 2; ++k) acc[ai][bj][m][n] = __builtin_amdgcn_mfma_f32_16x16x32_bf16(Bt[n][k], At[m][k], acc[ai][bj][m][n], 0, 0, 0); } } __builtin_amdgcn_s_setprio(0); } while (0)
#define PG8_WAIT_V(n) asm volatile("s_waitcnt vmcnt(" #n ")" ::: "memory")
#define PG8_WAIT_L(n) asm volatile("s_waitcnt lgkmcnt(" #n ")" ::: "memory")
#define PG8_BAR __builtin_amdgcn_s_barrier()
#define PG8_SCHED __builtin_amdgcn_sched_barrier(0)
#define PG8_KBODY(F) do { \
            const bool last = (t == nt - 2); \
            const char* a1 = cA + (size_t)(t + 1) * kstep; \
            const char* a2 = last ? nA : cA + (size_t)(t + 2) * kstep; const char* b2 = last ? nB : cB + (size_t)(t + 2) * kstep; \
            const char* a3 = a2 + kstep; const char* b3 = b2 + kstep; \
            if (last && has_next) S.a_ready(nxt); \
            PG8_LDB(F, B0, 0, 0); PG8_SCHED; PG8_LDA(F, At, 0, 0); PG8_STAGE(PG8_SA(1, 1), a1 + hstep, voffA); \
            PG8_WAIT_L(8); PG8_BAR; PG8_WAIT_L(0); PG8_MMA(F, 0, 0, At, B0); PG8_BAR; PG8_SCHED; \
            PG8_LDB(F, B1, 0, 1); PG8_STAGE(PG8_SB(0, 0), b2, voffB); \
            PG8_BAR; PG8_WAIT_L(0); PG8_MMA(F, 0, 1, At, B1); PG8_BAR; \
            PG8_LDA(F, At, 0, 1); PG8_STAGE(PG8_SA(0, 0), a2, voffA); \
            PG8_BAR; PG8_WAIT_L(0); PG8_MMA(F, 1, 0, At, B0); PG8_BAR; PG8_SCHED; \
            PG8_STAGE(PG8_SB(0, 1), b2 + hstep, voffB); \
            PG8_WAIT_V(6); PG8_BAR; PG8_MMA(F, 1, 1, At, B1); PG8_BAR; \
            PG8_LDB(F, B0, 1, 0); PG8_SCHED; PG8_LDA(F, At, 1, 0); PG8_STAGE(PG8_SA(0, 1), a2 + hstep, voffA); \
            PG8_WAIT_L(8); PG8_BAR; PG8_WAIT_L(0); PG8_MMA(F, 0, 0, At, B0); PG8_BAR; PG8_SCHED; \
            PG8_LDB(F, B1, 1, 1); PG8_STAGE(PG8_SB(1, 0), b3, voffB); \
            PG8_BAR; PG8_WAIT_L(0); PG8_MMA(F, 0, 1, At, B1); PG8_BAR; \
            PG8_LDA(F, At, 1, 1); PG8_STAGE(PG8_SA(1, 0), a3, voffA); \
            PG8_BAR; PG8_WAIT_L(0); PG8_MMA(F, 1, 0, At, B0); PG8_BAR; PG8_SCHED; \
            PG8_STAGE(PG8_SB(1, 1), b3 + hstep, voffB); \
            PG8_WAIT_V(6); PG8_BAR; PG8_MMA(F, 1, 1, At, B1); PG8_BAR; \
        } while (0)
    Unit cur, nxt; int ui = 0;
    if (!S.next(0, cur)) return;
    f32x4 acc[2][2][4][2];
#pragma unroll
    for (int a = 0; a < 2; ++a)
#pragma unroll
        for (int b = 0; b < 2; ++b)
#pragma unroll
            for (int m = 0; m < 4; ++m)
#pragma unroll
                for (int n = 0; n < 2; ++n) acc[a][b][m][n] = (f32x4){0.f, 0.f, 0.f, 0.f};
    bf16x8 At[4][2], B0[2][2], B1[2][2]; pg8_i8 At8[4], B08[2], B18[2]; int sc127 = 127; asm volatile("" : "+v"(sc127));
    const char* cA = (const char*)g.A + (size_t)cur.pm * tstep; const char* cB = (const char*)g.Bt + (size_t)cur.pn * tstep;
    S.a_ready(cur);
    PG8_STAGE(PG8_SB(0, 0), cB, voffB); PG8_STAGE(PG8_SA(0, 0), cA, voffA); PG8_STAGE(PG8_SB(0, 1), cB + hstep, voffB); PG8_STAGE(PG8_SA(0, 1), cA + hstep, voffA);
    if (wr == 1) PG8_BAR;
    PG8_WAIT_V(4); PG8_BAR;
    PG8_STAGE(PG8_SB(1, 0), cB + kstep, voffB); PG8_STAGE(PG8_SA(1, 0), cA + kstep, voffA); PG8_STAGE(PG8_SB(1, 1), cB + hstep + kstep, voffB);
    PG8_WAIT_V(6); PG8_BAR;
    PG8_STAMP();
    for (;;) {
        const bool has_next = S.next(ui + 1, nxt);
        const char* nA = has_next ? (const char*)g.A + (size_t)nxt.pm * tstep : cA; const char* nB = has_next ? (const char*)g.Bt + (size_t)nxt.pn * tstep : cB;
        { int t = 0;
          if constexpr (FP8 && NBF > 0) { for (; t < NBF; t += 2) PG8_KBODY(false); }
          for (; t < nt; t += 2) PG8_KBODY(FP8); }
        PG8_STAMP();
        if constexpr (FP8) { asm volatile("s_nop 15\n\ts_nop 15" ::: "memory"); }
        if constexpr (!Epi::AFTER_DRAIN) { E(acc, cur, wr, wc, fr, fq); S.done(cur); }
        PG8_STAMP();
        if (!has_next) break;
#pragma unroll
        for (int a = 0; a < 2; ++a)
#pragma unroll
            for (int b = 0; b < 2; ++b)
#pragma unroll
                for (int m = 0; m < 4; ++m)
#pragma unroll
                    for (int n = 0; n < 2; ++n) acc[a][b][m][n] = (f32x4){0.f, 0.f, 0.f, 0.f};
        cur = nxt; cA = nA; cB = nB; ++ui;
    }
    PG8_WAIT_V(0);
    if (wr == 0) PG8_BAR;
    PG8_BAR;
    if constexpr (Epi::AFTER_DRAIN) { E.fused(acc, cur, wr, wc, fr, fq, lds, wid, lane); S.done(cur); }
    PG8_STAMP();
    if (STAMP && wid == 0) { stamps[lane] = lane < nts ? (((unsigned long long)(unsigned)ts_hi << 32) | (unsigned)ts_lo) : 0ull;
        if (lane == 62) stamps[62] = rt_entry; if (lane == 63) stamps[63] = (unsigned long long)wall_clock64(); }
#undef PG8_STAMP
#undef PG8_SA
#undef PG8_SB
#undef PG8_STAGE
#undef PG8_LDA
#undef PG8_LDB
#undef PG8_MMA
#undef PG8_KBODY
#undef PG8_CAT
#undef PG8_WAIT_V
#undef PG8_WAIT_L
#undef PG8_BAR
#undef PG8_SCHED
}
}
#define XB_TMO      128
#define XB_XCNT(j)  (256  + 64 * (j))
#define XB_XSUB(j)  (1280 + 64 * (j))
#define XB_XGEN(j)  (2304 + 64 * (j))
#define XB_TOP      3328
#define XB_TOPGEN   3392
#define XCD_BAR_WORDS 3456
#define XB_SPIN_CAP (1u << 18)

__device__ __forceinline__ unsigned xb_ld(unsigned* p)              { return __hip_atomic_load(p, __ATOMIC_RELAXED, __HIP_MEMORY_SCOPE_AGENT); }
__device__ __forceinline__ unsigned xb_add(unsigned* p, unsigned v) { return __hip_atomic_fetch_add(p, v, __ATOMIC_RELAXED, __HIP_MEMORY_SCOPE_AGENT); }
__device__ __forceinline__ unsigned xb_xcc_id() { return (unsigned)__builtin_amdgcn_s_getreg((3 << 11) | 20) & 0xFu; }
#define XB_SPIN(cond, bar) do { unsigned _sp = 0; while (cond) { __builtin_amdgcn_s_sleep(1); \
    if ((++_sp & 255u) == 0u) { if (xb_ld(&(bar)[XB_TMO])) break; if (_sp > XB_SPIN_CAP) { atomicAdd(&(bar)[XB_TMO], 1u); break; } } } } while (0)

struct XcdBarrier {
    unsigned* bar; unsigned x;
    volatile LAS unsigned* st;
};

__device__ __forceinline__ XcdBarrier xcd_barrier_post(unsigned* bar, volatile LAS unsigned* st) {
    XcdBarrier b; b.bar = bar; b.x = xb_xcc_id(); b.st = st;
    if (threadIdx.x == 0) (void)xb_add(&bar[XB_XCNT(b.x)], 1u);
    return b;
}
__device__ __forceinline__ void xcd_barrier_complete(unsigned* bar, unsigned x, unsigned& nloc, unsigned& nx) {
    const unsigned G = gridDim.x * gridDim.y * gridDim.z;
    unsigned sum, cnt, mine, sp = 0u;
    for (;;) {
        sum = 0u; cnt = 0u; mine = 0u;
#pragma unroll
        for (unsigned j = 0; j < 16; ++j) { const unsigned c = xb_ld(&bar[XB_XCNT(j)]); sum += c; cnt += (c > 0u) ? 1u : 0u; mine = (j == x) ? c : mine; }
        if (sum == G) break;
        __builtin_amdgcn_s_sleep(1);
        if ((++sp & 255u) == 0u) { if (xb_ld(&bar[XB_TMO])) break; if (sp > XB_SPIN_CAP) { atomicAdd(&bar[XB_TMO], 1u); break; } }
    }
    nloc = mine > 0u ? mine : 1u; nx = cnt > 0u ? cnt : 1u;
}

__device__ __forceinline__ void xcd_barrier(const XcdBarrier& b) {
    asm volatile("s_waitcnt vmcnt(0)" ::: "memory");
    __syncthreads();
    if (threadIdx.x == 0) {
        unsigned* bar = b.bar;
        __builtin_amdgcn_s_waitcnt(0);
        unsigned nloc = b.st[0], nx = b.st[1];
        if (nloc == 0u) { xcd_barrier_complete(bar, b.x, nloc, nx); b.st[0] = nloc; b.st[1] = nx; }
        const unsigned old = xb_add(&bar[XB_XSUB(b.x)], 1u);
        const unsigned gen = old / nloc;
        if (old + 1u == (gen + 1u) * nloc) {
            __builtin_amdgcn_fence(__ATOMIC_RELEASE, "agent");
            asm volatile("s_waitcnt vmcnt(0)" ::: "memory");
            const unsigned og = xb_add(&bar[XB_TOP], 1u);
            const unsigned tg = og / nx;
            if (og + 1u == (tg + 1u) * nx) xb_add(&bar[XB_TOPGEN], 1u);
            else XB_SPIN(xb_ld(&bar[XB_TOPGEN]) == tg, bar);
            __builtin_amdgcn_fence(__ATOMIC_ACQUIRE, "agent");
            xb_add(&bar[XB_XGEN(b.x)], 1u);
            asm volatile("s_waitcnt vmcnt(0)" ::: "memory");
        } else {
            XB_SPIN(xb_ld(&bar[XB_XGEN(b.x)]) == gen, bar);
            __builtin_amdgcn_fence(__ATOMIC_ACQUIRE, "agent");
            asm volatile("s_waitcnt vmcnt(0)" ::: "memory");
        }
    }
    __syncthreads();
}
namespace {
struct EpiResid {
    static constexpr bool PERM = false, AFTER_DRAIN = false;
    const float* X; float* C; int ldc; const float* gate;
    __device__ __forceinline__ void operator()(const pg8::f32x4 (&acc)[2][2][4][2], const pg8::Unit& u, int wr, int wc, int fr, int fq) const {
        using pg8::f32x4; using pg8::HALF; using pg8::BM;
        const int row0 = u.pm * BM + wr * 64 + fr, col0 = u.pn * BM + wc * 32 + 4 * fq;
        const float* gp = gate + (size_t)(u.pm >> 3) * NMOD;
        f32x4 gv[2][2];
#pragma unroll
        for (int bj = 0; bj < 2; ++bj)
#pragma unroll
            for (int n = 0; n < 2; ++n) gv[bj][n] = *(const f32x4*)(gp + col0 + bj * HALF + n * 16);
#pragma unroll
        for (int ai = 0; ai < 2; ++ai)
#pragma unroll
            for (int m = 0; m < 4; ++m) { const size_t off = (size_t)(row0 + ai * HALF + m * 16) * ldc + col0;
#pragma unroll
                for (int bj = 0; bj < 2; ++bj)
#pragma unroll
                    for (int n = 0; n < 2; ++n) { const f32x4 xv = *(const f32x4*)(X + off + bj * HALF + n * 16); *(f32x4*)(C + off + bj * HALF + n * 16) = xv + gv[bj][n] * acc[ai][bj][m][n]; }
                asm volatile("" ::: "memory"); }
    }
};

struct Args {
    const float* in[19]; float* out; unsigned char* ws; int ph_lo, ph_hi, li, pad;
};
constexpr size_t WS_CTL = 0;
constexpr size_t WS_MOD = 65536;
constexpr size_t WS_WINT = WS_MOD + (size_t)NB * NMOD * 4;
constexpr size_t WS_WOUTT = WS_WINT + (size_t)PLD * DM * 2;
constexpr size_t WS_WPQT = WS_WOUTT + (size_t)DM * DM * 2;
constexpr size_t WS_H = WS_WPQT + (size_t)2048 * DM * 2;
constexpr size_t WS_PROJ = WS_H + (size_t)NTOK * DM * 2;
constexpr size_t WS_MIX = WS_PROJ + (size_t)NTOK * PLD * 2;
constexpr size_t WS_QP = WS_MIX + (size_t)NTOK * DM * 2;
constexpr size_t WS_END_A = WS_QP + (size_t)NTOK * 2048 * 2;

constexpr int MOD_KS = 21;
__device__ __forceinline__ void p0_mod(const float* c, const float* w_ada, float* part, LAS unsigned char* lds, int blk) {
    const int tid = threadIdx.x;
    if (blk >= 12 * MOD_KS) return;
    const int cs = blk % 12, ks = blk / 12, kbeg = ks * 196, kend = (kbeg + 196 < DM) ? kbeg + 196 : DM, nk = kend - kbeg;
    LAS float* sc = (LAS float*)lds;
    for (int i = tid; i < nk * 8; i += NTHR) { const int b = i & 7, k = kbeg + (i >> 3); const float v = c[b * DM + k]; sc[i] = v / (1.0f + __expf(-v)); }
    __syncthreads();
    const int col = cs * 2048 + tid * 4;
    float acc[NB][4];
#pragma unroll
    for (int b = 0; b < NB; ++b)
#pragma unroll
        for (int j = 0; j < 4; ++j) acc[b][j] = 0.f;
    const float* wp = w_ada + (size_t)kbeg * NMOD + col;
    for (int k0 = 0; k0 < nk; k0 += 16) {
        float4 w[16];
#pragma unroll
        for (int u = 0; u < 16; ++u) { w[u] = make_float4(0.f, 0.f, 0.f, 0.f); if (k0 + u < nk) { const f4 t_ = __builtin_nontemporal_load((const f4*)(wp + (size_t)(k0 + u) * NMOD)); w[u] = make_float4(t_[0], t_[1], t_[2], t_[3]); } }
#pragma unroll
        for (int u = 0; u < 16; ++u) { const int k = (k0 + u < nk) ? k0 + u : 0;
            const f4 s0 = *(const LAS f4*)(sc + k * 8), s1 = *(const LAS f4*)(sc + k * 8 + 4);
            const float sv[8] = {s0[0], s0[1], s0[2], s0[3], s1[0], s1[1], s1[2], s1[3]};
#pragma unroll
            for (int b = 0; b < NB; ++b) { acc[b][0] += sv[b] * w[u].x; acc[b][1] += sv[b] * w[u].y; acc[b][2] += sv[b] * w[u].z; acc[b][3] += sv[b] * w[u].w; } }
    }
#pragma unroll
    for (int b = 0; b < NB; ++b) *(float4*)(part + ((size_t)ks * NB + b) * NMOD + col) = make_float4(acc[b][0], acc[b][1], acc[b][2], acc[b][3]);
    __syncthreads();
}
__device__ __forceinline__ float mod_reduce(const float* part, const float* b_ada, int b, int j) {
    float s = b_ada[j];
#pragma unroll
    for (int ks = 0; ks < MOD_KS; ++ks) s += part[((size_t)ks * NB + b) * NMOD + j];
    return s;
}
__device__ __forceinline__ void p0_transpose(const float* W, int K, int N, int Npad, bf16_t* Wt, LAS unsigned char* lds, int blk, int nblk, unsigned* amax = nullptr) {
    const int tid = threadIdx.x; LAS float* tile = (LAS float*)lds;
    const int tk = K / 64, tn = Npad / 64, ntile = tk * tn;
    for (int t0 = blk * 8; t0 < ntile; t0 += nblk * 8) {
        float4 v[8][2];
#pragma unroll
        for (int q = 0; q < 8; ++q) { const int t = t0 + q; const int k0 = (t % tk) * 64, n0 = (t / tk) * 64;
#pragma unroll
            for (int p = 0; p < 2; ++p) { const int r = (tid >> 4) + p * 32, c4 = (tid & 15) * 4; v[q][p] = make_float4(0.f, 0.f, 0.f, 0.f);
                if (t < ntile && n0 + c4 < N) { const f4 t_ = __builtin_nontemporal_load((const f4*)(W + (size_t)(k0 + r) * N + n0 + c4)); v[q][p] = make_float4(t_[0], t_[1], t_[2], t_[3]); } } }
#pragma unroll
        for (int q = 0; q < 8; ++q)
#pragma unroll
            for (int p = 0; p < 2; ++p) { const int r = (tid >> 4) + p * 32, c4 = (tid & 15) * 4; LAS float* tp = tile + q * 4160 + r * 65 + c4;
                tp[0] = v[q][p].x; tp[1] = v[q][p].y; tp[2] = v[q][p].z; tp[3] = v[q][p].w; }
        __syncthreads();
#pragma unroll
        for (int q = 0; q < 8; ++q) { const int t = t0 + q; const int k0 = (t % tk) * 64, n0 = (t / tk) * 64; const LAS float* tq = tile + q * 4160;
            if (t < ntile) { const int n = tid >> 3, ks = (tid & 7) * 8; uint4 o;
                o.x = pk_bf16(tq[(ks + 0) * 65 + n], tq[(ks + 1) * 65 + n]); o.y = pk_bf16(tq[(ks + 2) * 65 + n], tq[(ks + 3) * 65 + n]);
                o.z = pk_bf16(tq[(ks + 4) * 65 + n], tq[(ks + 5) * 65 + n]); o.w = pk_bf16(tq[(ks + 6) * 65 + n], tq[(ks + 7) * 65 + n]);
                *(uint4*)(Wt + (size_t)(n0 + n) * K + k0 + ks) = o;
                if (amax) { float m = 0.f;
#pragma unroll
                    for (int e = 0; e < 8; ++e) m = fmaxf(m, fabsf(tq[(ks + e) * 65 + n]));
                    m = fmaxf(m, __shfl_xor(m, 1)); m = fmaxf(m, __shfl_xor(m, 2)); m = fmaxf(m, __shfl_xor(m, 4));
                    if ((tid & 7) == 0) atomicMax(amax + n0 + n, __float_as_uint(m)); } } }
        __syncthreads();
    }
}
template <bool FROM_PART>
__device__ __forceinline__ void p_norm_mod(const float* x, const float* g, const float* mod, const float* part, const float* b_ada, float* mod_out, int shift_off, int scale_off, bf16_t* H, LAS unsigned char* lds, int blk, unsigned char* Hq = nullptr, float* hqs = nullptr) {
    const int tid = threadIdx.x, lane = tid & 63, wv = tid >> 6; const int b = (blk * 64) / NT;
    LAS float* av = (LAS float*)lds; LAS float* sv = av + DM;
    if (FROM_PART) {
        for (int i = tid; i < DM; i += NTHR) { av[i] = g[i] * (1.0f + mod_reduce(part, b_ada, b, scale_off + i)); sv[i] = mod_reduce(part, b_ada, b, shift_off + i); }
        for (int o = blk * 768 + tid; o < blk * 768 + 768; o += NTHR) mod_out[o] = mod_reduce(part, b_ada, o / NMOD, o % NMOD);
    } else {
        for (int i = tid; i < DM; i += NTHR) { av[i] = g[i] * (1.0f + mod[(size_t)b * NMOD + scale_off + i]); sv[i] = mod[(size_t)b * NMOD + shift_off + i]; }
    }
    __syncthreads();
    float4 v[16];
    { const float* xr = x + (size_t)(blk * 64 + wv) * DM;
#pragma unroll
      for (int i = 0; i < 16; ++i) v[i] = *(const float4*)(xr + i * 256 + lane * 4); }
#pragma unroll 1
    for (int tt = wv; tt < 64; tt += NWAVES) {
        const int tok = blk * 64 + tt; float4 nv[16];
        if (tt + NWAVES < 64) { const float* xn = x + (size_t)(tok + NWAVES) * DM;
#pragma unroll
            for (int i = 0; i < 16; ++i) nv[i] = *(const float4*)(xn + i * 256 + lane * 4); }
        float ss = 0.f;
#pragma unroll
        for (int i = 0; i < 16; ++i) ss += v[i].x * v[i].x + v[i].y * v[i].y + v[i].z * v[i].z + v[i].w * v[i].w;
        ss = wave_sum(ss); const float rstd = rsqrtf(ss * (1.0f / DM) + 1e-6f);
        float hm = 0.f;
#pragma unroll
        for (int i = 0; i < 16; ++i) { const int col = i * 256 + lane * 4; const f4 a = *(const LAS f4*)(av + col), s = *(const LAS f4*)(sv + col);
            v[i].x = v[i].x * rstd * a.x + s.x; v[i].y = v[i].y * rstd * a.y + s.y; v[i].z = v[i].z * rstd * a.z + s.z; v[i].w = v[i].w * rstd * a.w + s.w;
            hm = fmaxf(hm, fmaxf(fmaxf(fabsf(v[i].x), fabsf(v[i].y)), fmaxf(fabsf(v[i].z), fabsf(v[i].w))));
            uint2 o; o.x = pk_bf16(v[i].x, v[i].y); o.y = pk_bf16(v[i].z, v[i].w);
            *(uint2*)(H + (size_t)tok * DM + col) = o; }
        if (Hq) { hm = wave_max(hm); const float qi = hm > 0.f ? 119.0f / hm : 0.f;
            if (lane == 0) hqs[tok] = hm * (1.0f / 119.0f);
#pragma unroll
            for (int i = 0; i < 16; ++i) { const int col = i * 256 + lane * 4;
                const int q4[4] = {__float2int_rn(v[i].x * qi), __float2int_rn(v[i].y * qi), __float2int_rn(v[i].z * qi), __float2int_rn(v[i].w * qi)};
                unsigned hh = 0u, hl = 0u;
#pragma unroll
                for (int e = 0; e < 4; ++e) { const int lo = ((q4[e] + 8) & 15) - 8, hi = (q4[e] - lo) >> 4; hl |= ((unsigned)lo & 15u) << (4 * e); hh |= ((unsigned)hi & 15u) << (4 * e); }
                const unsigned oddl = lane & 1;
                const unsigned pv = (unsigned)__shfl_xor((int)(oddl ? hh : hl), 1);
                *(unsigned*)(Hq + (size_t)tok * DM + col) = oddl ? (pv | (hl << 16)) : (hh | (pv << 16)); } }
        if (tt + NWAVES < 64) {
#pragma unroll
            for (int i = 0; i < 16; ++i) v[i] = nv[i]; }
    }
    __syncthreads();
}
}
namespace {
typedef __bf16 bf16x2_t __attribute__((ext_vector_type(2)));
typedef short bf16x8 __attribute__((ext_vector_type(8)));
typedef float f32x16 __attribute__((ext_vector_type(16)));
typedef unsigned u4 __attribute__((ext_vector_type(4)));
__device__ __forceinline__ float dot2c(unsigned a, unsigned b, float acc) { return __builtin_amdgcn_fdot2_f32_bf16(__builtin_bit_cast(bf16x2_t, a), __builtin_bit_cast(bf16x2_t, b), acc, false); }

constexpr size_t PEER_SLAB = (size_t)16384 * 128;
constexpr size_t WS_UB = WS_END_A;
constexpr size_t WS_VB = WS_UB + 32 * PEER_SLAB;
constexpr size_t WS_KEYSB = WS_VB + 32 * PEER_SLAB;
constexpr size_t WS_EIDX = WS_KEYSB + (size_t)16 * 128 * 128 * 2;
constexpr size_t WS_GW = WS_EIDX + (size_t)NTOK * 128 * 4;
constexpr size_t WS_PW = WS_GW + (size_t)NTOK * 128 * 4;
constexpr size_t WS_END_B = WS_PW + (size_t)NTOK * 128 * 4;

__device__ __forceinline__ void p0_peer_cvt(const float* src, bf16_t* dst, int blk, int nblk) {
    const int tid = threadIdx.x, w = tid >> 6, lane = tid & 63;
    for (int eb = blk; eb < 256; eb += nblk) {
        const int e = eb * 64 + w * 8 + (lane >> 3);
        const float* r = src + (size_t)e * DM + (lane & 7) * 8; bf16_t* d = dst + (size_t)e * 64 + (lane & 7) * 8;
#pragma unroll 1
        for (int c0 = 0; c0 < 64; c0 += 8) {
            float4 a[8], b[8];
#pragma unroll
            for (int u = 0; u < 8; ++u) { a[u] = *(const float4*)(r + (c0 + u) * 64); b[u] = *(const float4*)(r + (c0 + u) * 64 + 4); }
#pragma unroll
            for (int u = 0; u < 8; ++u) { uint4 o; o.x = pk_bf16(a[u].x, a[u].y); o.y = pk_bf16(a[u].z, a[u].w); o.z = pk_bf16(b[u].x, b[u].y); o.w = pk_bf16(b[u].z, b[u].w);
                *(uint4*)(d + (size_t)(c0 + u) * 16384 * 64) = o; }
        }
    }
}
__device__ __forceinline__ void p0_cvt_flat(const float* src, bf16_t* dst, int n, int blk, int nblk) {
    for (int i = (blk * NTHR + threadIdx.x) * 4; i < n; i += nblk * NTHR * 4) { const float4 v = *(const float4*)(src + i); uint2 o; o.x = pk_bf16(v.x, v.y); o.y = pk_bf16(v.z, v.w); *(uint2*)(dst + i) = o; }
}

__device__ __forceinline__ int f2key(float f) { const int b = __float_as_int(f); return b ^ ((b >> 31) & 0x7fffffff); }
__device__ __forceinline__ float key2f(int k) { return __int_as_float(k ^ ((k >> 31) & 0x7fffffff)); }
#define CE_DESC(a, b) do { const int _mx = max(a, b), _mn = min(a, b); a = _mx; b = _mn; } while (0)
__device__ __forceinline__ void sort16_desc(int (&v)[16]) {
#pragma unroll
    for (int lk = 1; lk <= 4; ++lk)
#pragma unroll
        for (int lj = lk - 1; lj >= 0; --lj)
#pragma unroll
            for (int i = 0; i < 16; ++i) { const int k = 1 << lk, j = 1 << lj, l = i ^ j;
                if (l > i) { if ((i & k) == 0 || k == 16) { CE_DESC(v[i], v[l]); } else { CE_DESC(v[l], v[i]); } } }
}
__device__ __forceinline__ void merge16_desc(int (&v)[16]) {
#pragma unroll
    for (int lj = 3; lj >= 0; --lj)
#pragma unroll
        for (int i = 0; i < 16; ++i) { const int j = 1 << lj, l = i ^ j; if (l > i) CE_DESC(v[i], v[l]); }
}
__device__ __forceinline__ void top16_of_64(const int (&v)[64], int (&o)[16]) {
    int g[4][16];
#pragma unroll
    for (int q = 0; q < 4; ++q) {
#pragma unroll
        for (int i = 0; i < 16; ++i) g[q][i] = v[q * 16 + i];
        sort16_desc(g[q]); }
#pragma unroll
    for (int i = 0; i < 16; ++i) { g[0][i] = max(g[0][i], g[1][15 - i]); g[2][i] = max(g[2][i], g[3][15 - i]); }
    merge16_desc(g[0]); merge16_desc(g[2]);
#pragma unroll
    for (int i = 0; i < 16; ++i) o[i] = max(g[0][i], g[2][15 - i]);
    merge16_desc(o);
}
__device__ __forceinline__ void p8_topk(const bf16_t* QP, const bf16_t* KEYS, unsigned* eidx, float* gw, LAS unsigned char* lds, int blk, int nblk) {
    const int tid = threadIdx.x, h = __builtin_amdgcn_readfirstlane(tid >> 6), lane = tid & 63, r32 = lane & 31, hi = lane >> 5;
    LAS int* slot = (LAS int*)lds + h * 32 * 64 + lane;
    LAS unsigned char* pct = lds + 65536;
    if (tid == 0) { int pc = 0; for (int i = 0; i < 16; ++i) for (int j = 0; j < 16; ++j) if ((i + 1) * (j + 1) <= 16) pct[pc++] = (unsigned char)(i * 16 + j); }
    __syncthreads();
    for (int tb = 2 * blk; tb < 2 * blk + 2 && tb < NTOK / 32; ++tb) {
        const int tok = tb * 32 + r32;
        int vs[2][16];
#pragma unroll
        for (int c = 0; c < 2; ++c) {
            const int list = h * 2 + c;
            bf16x8 qf[8];
#pragma unroll
            for (int d0 = 0; d0 < 8; ++d0) qf[d0] = *(const bf16x8*)(QP + (size_t)tok * 2048 + list * 128 + d0 * 16 + hi * 8);
            int v[64];
#pragma unroll
            for (int kt = 0; kt < 4; ++kt) {
                f32x16 s = {};
                const bf16_t* kp = KEYS + ((size_t)(list * 4 + kt) * 8) * 512 + lane * 8; asm volatile("" : "+v"(kp));
#pragma unroll
                for (int d0 = 0; d0 < 8; ++d0) { const bf16x8 kf = *(const bf16x8*)(kp + d0 * 512);
                    s = __builtin_amdgcn_mfma_f32_32x32x16_bf16(kf, qf[d0], s, 0, 0, 0); }
#pragma unroll
                for (int r = 0; r < 16; ++r) v[kt * 16 + r] = (f2key(s[r]) & ~127) | (hi << 6) | (kt * 16 + r);
                asm volatile("" ::: "memory"); __builtin_amdgcn_sched_barrier(0);
            }
            int t[16]; top16_of_64(v, t);
#pragma unroll
            for (int i = 0; i < 16; ++i) { const int p = __shfl_xor(t[15 - i], 32); vs[c][i] = max(t[i], p); }
            merge16_desc(vs[c]);
#pragma unroll
            for (int i = 0; i < 16; ++i) slot[(c * 16 + i) * 64] = vs[c][i];
            asm volatile("" ::: "memory"); __builtin_amdgcn_sched_barrier(0);
        }
        int cv[64]; int pc = 0;
#pragma unroll
        for (int i = 0; i < 16; ++i)
#pragma unroll
            for (int j = 0; j < 16; ++j) if ((i + 1) * (j + 1) <= 16) { cv[pc] = (f2key(key2f(vs[0][i]) + key2f(vs[1][j])) & ~63) | pc; ++pc; }
#pragma unroll
        for (int q = 50; q < 64; ++q) cv[q] = (int)0x80000000;
        int w[16]; top16_of_64(cv, w);
        const float m = key2f(w[0]); float p[16], den = 0.f; unsigned ee[16];
#pragma unroll
        for (int k = 0; k < 16; ++k) { p[k] = __expf(key2f(w[k]) - m); den += p[k];
            const int ij = pct[w[k] & 63]; const int c1 = slot[(ij >> 4) * 64] & 127, c2 = slot[(16 + (ij & 15)) * 64] & 127;
            const int k1 = ((c1 >> 4) & 3) * 32 + (c1 & 3) + 8 * ((c1 >> 2) & 3) + 4 * (c1 >> 6), k2 = ((c2 >> 4) & 3) * 32 + (c2 & 3) + 8 * ((c2 >> 2) & 3) + 4 * (c2 >> 6);
            ee[k] = (unsigned)(k1 * 128 + k2); }
        const float rden = 1.0f / den; const unsigned hm = (unsigned)(-hi);
        u4 e0, e1; f4 g0, g1;
#pragma unroll
        for (int k = 0; k < 4; ++k) {
            e0[k] = ee[k] ^ ((ee[k] ^ ee[8 + k]) & hm); e1[k] = ee[4 + k] ^ ((ee[4 + k] ^ ee[12 + k]) & hm);
            const unsigned pa = __float_as_uint(p[k]), pb = __float_as_uint(p[8 + k]), pc2 = __float_as_uint(p[4 + k]), pd = __float_as_uint(p[12 + k]);
            g0[k] = __uint_as_float(pa ^ ((pa ^ pb) & hm)) * rden; g1[k] = __uint_as_float(pc2 ^ ((pc2 ^ pd) & hm)) * rden; }
        const size_t o = (size_t)tok * 128 + h * 16 + hi * 8;
        *(u4*)(eidx + o) = e0; *(u4*)(eidx + o + 4) = e1; *(f4*)(gw + o) = g0; *(f4*)(gw + o + 4) = g1;
    }
    __syncthreads();
}

__device__ __forceinline__ void p9_peer_u(const bf16_t* H, const bf16_t* Ub, const unsigned* eidx, const float* gw, float* pw, LAS unsigned char* lds, int blk) {
    const int tid = threadIdx.x, wv = tid >> 6, lane = tid & 63, tl = lane >> 3, j = lane & 7;
    LAS unsigned* eo = (LAS unsigned*)lds;
    const int base = blk * 64;
    for (int i = tid; i < 64 * 128; i += NTHR) eo[i] = eidx[(size_t)base * 128 + i] * 128u;
    __syncthreads();
    const int tok = base + wv * 8 + tl;
    const LAS unsigned* myeo = eo + (wv * 8 + tl) * 128;
    float acc[128];
#pragma unroll
    for (int k = 0; k < 128; ++k) acc[k] = 0.f;
    const bf16_t* hrow = H + (size_t)tok * DM + j * 8;
    for (int c = 0; c < 64; ++c) {
        const uint4 hv = *(const uint4*)(hrow + c * 64);
        const unsigned char* slab = (const unsigned char*)Ub + (size_t)c * PEER_SLAB + j * 16;
        uint4 ub[2][8];
#define P9_LOAD(g, B) do { const u4 oa = *(const LAS u4*)(myeo + (g) * 8), ob = *(const LAS u4*)(myeo + (g) * 8 + 4); \
            _Pragma("unroll") for (int q = 0; q < 4; ++q) { ub[B][q] = *(const uint4*)(slab + oa[q]); ub[B][4 + q] = *(const uint4*)(slab + ob[q]); } \
            asm volatile("" ::: "memory"); __builtin_amdgcn_sched_barrier(0); } while (0)
#define P9_DOT(g, B) do { _Pragma("unroll") for (int q = 0; q < 8; ++q) { float a = acc[(g) * 8 + q]; const uint4 u = ub[B][q]; \
            a = dot2c(u.x, hv.x, a); a = dot2c(u.y, hv.y, a); a = dot2c(u.z, hv.z, a); a = dot2c(u.w, hv.w, a); acc[(g) * 8 + q] = a; } } while (0)
        P9_LOAD(0, 0);
#pragma unroll
        for (int g = 0; g < 16; g += 2) {
            P9_LOAD(g + 1, 1); P9_DOT(g, 0);
            if (g + 2 < 16) P9_LOAD(g + 2, 0);
            P9_DOT(g + 1, 1);
        }
#undef P9_LOAD
#undef P9_DOT
    }
#pragma unroll
    for (int i = 0; i < 64; ++i) { const bool up = (j & 4) != 0; const float snd = up ? acc[i] : acc[i + 64], kp = up ? acc[i + 64] : acc[i]; acc[i] = kp + __shfl_xor(snd, 4); }
#pragma unroll
    for (int i = 0; i < 32; ++i) { const bool up = (j & 2) != 0; const float snd = up ? acc[i] : acc[i + 32], kp = up ? acc[i + 32] : acc[i]; acc[i] = kp + __shfl_xor(snd, 2); }
#pragma unroll
    for (int i = 0; i < 16; ++i) { const bool up = (j & 1) != 0; const float snd = up ? acc[i] : acc[i + 16], kp = up ? acc[i + 16] : acc[i]; acc[i] = kp + __shfl_xor(snd, 1); }
    const int k0 = ((j >> 2) & 1) * 64 + ((j >> 1) & 1) * 32 + (j & 1) * 16;
    const float* gp = gw + (size_t)tok * 128 + k0; float* wp = pw + (size_t)tok * 128 + k0;
#pragma unroll
    for (int i = 0; i < 16; i += 4) { f4 g = *(const f4*)(gp + i); g[0] *= gelu_exact(acc[i]); g[1] *= gelu_exact(acc[i + 1]); g[2] *= gelu_exact(acc[i + 2]); g[3] *= gelu_exact(acc[i + 3]); *(f4*)(wp + i) = g; }
    __syncthreads();
}

__device__ __forceinline__ void p10_peer_v(const bf16_t* Vb, const unsigned* eidx, const float* gw, const float* gate2, const float* x1, float* out, LAS unsigned char* lds, int blk) {
    const int tid = threadIdx.x, wv = tid >> 6, lane = tid & 63, tl = lane >> 3, j = lane & 7;
    LAS unsigned* eo = (LAS unsigned*)lds; LAS unsigned* wl = eo + 64 * 128;
    const int base = blk * 64;
    for (int i = tid; i < 64 * 128; i += NTHR) { eo[i] = eidx[(size_t)base * 128 + i] * 128u; wl[i] = (unsigned)f2bf(gw[(size_t)base * 128 + i]); }
    __syncthreads();
    const int tok = base + wv * 8 + tl, b = tok / NT;
    const LAS unsigned* myeo = eo + (wv * 8 + tl) * 128; const LAS unsigned* mywl = wl + (wv * 8 + tl) * 128;
    for (int c = 0; c < 64; ++c) {
        const unsigned char* slab = (const unsigned char*)Vb + (size_t)c * PEER_SLAB + j * 16;
        float acc[8];
#pragma unroll
        for (int i = 0; i < 8; ++i) acc[i] = 0.f;
#pragma unroll 8
        for (int k4 = 0; k4 < 32; ++k4) {
            const u4 o4 = *(const LAS u4*)(myeo + k4 * 4); const u4 w4 = *(const LAS u4*)(mywl + k4 * 4);
#pragma unroll
            for (int q = 0; q < 4; ++q) { const uint4 u = *(const uint4*)(slab + o4[q]); const unsigned wlo = w4[q], whi = wlo << 16;
                acc[0] = dot2c(u.x, wlo, acc[0]); acc[1] = dot2c(u.x, whi, acc[1]); acc[2] = dot2c(u.y, wlo, acc[2]); acc[3] = dot2c(u.y, whi, acc[3]);
                acc[4] = dot2c(u.z, wlo, acc[4]); acc[5] = dot2c(u.z, whi, acc[5]); acc[6] = dot2c(u.w, wlo, acc[6]); acc[7] = dot2c(u.w, whi, acc[7]); }
        }
        const int col = c * 64 + j * 8; float* op = out + (size_t)tok * DM + col; const float* xp = x1 + (size_t)tok * DM + col; const float* gp = gate2 + (size_t)b * NMOD + col;
        f4 x0 = *(const f4*)xp, x1 = *(const f4*)(xp + 4); const f4 g0 = *(const f4*)gp, g1 = *(const f4*)(gp + 4);
        x0[0] += g0[0] * acc[0]; x0[1] += g0[1] * acc[1]; x0[2] += g0[2] * acc[2]; x0[3] += g0[3] * acc[3];
        x1[0] += g1[0] * acc[4]; x1[1] += g1[1] * acc[5]; x1[2] += g1[2] * acc[6]; x1[3] += g1[3] * acc[7];
        *(f4*)op = x0; *(f4*)(op + 4) = x1;
    }
    __syncthreads();
}
}
namespace {
typedef unsigned u2 __attribute__((ext_vector_type(2)));
constexpr size_t WS_ROPE = WS_END_B;
constexpr size_t WS_WPT = WS_ROPE + (size_t)2 * NT * 64 * 4;
constexpr size_t WS_W1T = WS_WPT + (size_t)4 * 256 * 256 * 2;
constexpr size_t WS_W2T = WS_W1T + (size_t)2 * 256 * 4096 * 2;
constexpr size_t WS_PEB = WS_W2T + (size_t)2 * 128 * 256 * 2;
constexpr size_t WS_KSEL = WS_PEB + 4096;
constexpr size_t WS_KWIN = WS_KSEL + (size_t)NTOK * 512 * 2;
constexpr size_t WS_CMPK = WS_KWIN + (size_t)NTOK * 512 * 2;
constexpr size_t WS_CMPV = WS_CMPK + (size_t)NB * 4 * 128 * 128 * 2;
constexpr size_t WS_OC = WS_CMPV + (size_t)NB * 4 * 128 * 128 * 2;
constexpr size_t WS_SELM = WS_OC + (size_t)NTOK * 3072 * 2;
constexpr size_t WS_PART = WS_SELM + (size_t)NTOK * 4 * 4;
constexpr size_t WS_END_C = WS_PART + (size_t)MOD_KS * NB * NMOD * 4;

__device__ __forceinline__ float sigmoidf_(float v) { return 1.0f / (1.0f + __expf(-v)); }
__device__ __forceinline__ void p0_rope(float* rope, int blk, int nblk) {
    for (int i = blk * NTHR + threadIdx.x; i < NT * 64; i += nblk * NTHR) { const int t = i >> 6, k = i & 63;
        const float inv = powf(10000.f, -(float)k / 64.f); float sn, cs; sincosf((float)t * inv, &sn, &cs); rope[i] = cs; rope[NT * 64 + i] = sn; }
}
__device__ __forceinline__ void p0_peb(const float* pe, const float* w1, float* peb, LAS unsigned char* lds, int blk) {
    if (blk >= 256) return;
    const int tid = threadIdx.x, kv = blk >> 7, h = (blk & 127) * 2; float a0 = 0.f, a1 = 0.f;
#pragma unroll
    for (int i = 0; i < 8; ++i) { const int k = tid + i * NTHR; const float p = pe[kv * 4096 + k]; const float2 w = *(const float2*)(w1 + ((size_t)kv * 4096 + k) * 256 + h); a0 += p * w.x; a1 += p * w.y; }
    a0 = wave_sum(a0); a1 = wave_sum(a1);
    LAS float* red = (LAS float*)lds;
    if ((tid & 63) == 0) { red[(tid >> 6) * 2] = a0; red[(tid >> 6) * 2 + 1] = a1; }
    __syncthreads();
    if (tid < 2) { float s = 0.f; for (int w = 0; w < NWAVES; ++w) s += red[w * 2 + tid]; peb[kv * 256 + h + tid] = s; }
    __syncthreads();
}

__device__ __forceinline__ void p0_frag(const float* src, size_t rstride, size_t cstride, int ntiles, int nsteps, bf16_t* dst, int blk, int nblk) {
    const int total = ntiles * nsteps * 64;
    for (int p = blk * NTHR + threadIdx.x; p < total; p += nblk * NTHR) {
        const int lane = p & 63, st = (p >> 6) % nsteps, tile = (p >> 6) / nsteps; const int row = tile * 32 + (lane & 31), col = st * 16 + (lane >> 5) * 8;
        const float* s = src + (size_t)row * rstride + (size_t)col * cstride; float v[8];
#pragma unroll
        for (int e = 0; e < 8; ++e) v[e] = s[(size_t)e * cstride];
        uint4 o; o.x = pk_bf16(v[0], v[1]); o.y = pk_bf16(v[2], v[3]); o.z = pk_bf16(v[4], v[5]); o.w = pk_bf16(v[6], v[7]);
        *(uint4*)(dst + (size_t)p * 8) = o;
    }
}
__device__ __forceinline__ void p3_knorm(const bf16_t* PROJ, const float* k_norm_g, const float* rope, bf16_t* KSEL, bf16_t* KWIN, int blk) {
    const int tid = threadIdx.x, l16 = tid & 15, vg = tid >> 4;
#pragma unroll 4
    for (int it = 0; it < 16; ++it) {
        const int task = it * 32 + vg, tok = blk * 64 + (task >> 3), s = task & 7, br = 1 + (s >> 2), g = s & 3, b = tok / NT, t = tok % NT;
        const uint4 u = *(const uint4*)(PROJ + (size_t)tok * PLD + KVOFF + ((br * 2 + 0) * 4 + g) * 128 + l16 * 8);
        const unsigned uu[4] = {u.x, u.y, u.z, u.w}; float xv[8]; float ss = 0.f;
#pragma unroll
        for (int e = 0; e < 4; ++e) { xv[2 * e] = __uint_as_float(uu[e] << 16); xv[2 * e + 1] = __uint_as_float(uu[e] & 0xffff0000u); ss += xv[2 * e] * xv[2 * e] + xv[2 * e + 1] * xv[2 * e + 1]; }
        ss += __shfl_xor(ss, 1); ss += __shfl_xor(ss, 2); ss += __shfl_xor(ss, 4); ss += __shfl_xor(ss, 8);
        const float rstd = rsqrtf(ss * (1.0f / 128.f) + 1e-6f);
        const float* gp = k_norm_g + br * 128 + l16 * 8; const f4 g0 = *(const f4*)gp, g1 = *(const f4*)(gp + 4);
        const float* cp = rope + t * 64 + (l16 & 7) * 8; const f4 c0 = *(const f4*)cp, c1 = *(const f4*)(cp + 4), s0 = *(const f4*)(cp + NT * 64), s1 = *(const f4*)(cp + NT * 64 + 4);
        float y[8], o[8];
#pragma unroll
        for (int e = 0; e < 8; ++e) y[e] = xv[e] * rstd * (e < 4 ? g0[e & 3] : g1[e & 3]);
#pragma unroll
        for (int e = 0; e < 8; ++e) { const float other = __shfl_xor(y[e], 8); const float cs = e < 4 ? c0[e & 3] : c1[e & 3], sn = e < 4 ? s0[e & 3] : s1[e & 3];
            o[e] = (l16 < 8) ? (y[e] * cs - other * sn) : (y[e] * cs + other * sn); }
        uint4 w; w.x = pk_bf16(o[0], o[1]); w.y = pk_bf16(o[2], o[3]); w.z = pk_bf16(o[4], o[5]); w.w = pk_bf16(o[6], o[7]);
        *(uint4*)((br == 1 ? KSEL : KWIN) + (((size_t)b * 4 + g) * NT + t) * 128 + l16 * 8) = w;
    }
}
__device__ __forceinline__ void p3_compress(const bf16_t* PROJ, const bf16_t* W1F, const bf16_t* W2T, const float* peb, const float* k_norm_g, bf16_t* CMPK, bf16_t* CMPV, LAS unsigned char* lds, int blk, int nblk) {
    const int tid = threadIdx.x, wv = __builtin_amdgcn_readfirstlane(tid >> 6), lane = tid & 63, r32 = lane & 31, hi = lane >> 5;
    LAS bf16_t* hidL = (LAS bf16_t*)lds;
    LAS float* ssL = (LAS float*)(lds + 32768);
    for (int item = blk; item < 256; item += nblk) {
        const int nt = item & 3, g = (item >> 2) & 3, b = (item >> 4) & 7, kv = item >> 7;
        int n = nt * 32 + r32;
        const int sr_ = tid >> 4, sc_ = (tid & 15) * 8; const int nrow = nt * 32 + sr_, ncl = nrow < NCMP ? nrow : NCMP - 1;
        const bf16_t* arow = PROJ + (size_t)(b * NT + 16 * ncl) * PLD + KVOFF + ((0 * 2 + kv) * 4 + g) * 128 + sc_;
        const bf16_t* wfr = W1F + ((size_t)(kv * 8 + wv) * 32 * 8) * 512 + lane * 8;
        LAS bf16_t* afL = (LAS bf16_t*)(lds + 49152);
        f32x16 acc = {};
        bf16x8 wfb[2][8]; uint4 astg;
#define CMP_LOAD(B, l) do { const bf16_t* wp = wfr + (size_t)(l) * 8 * 512; \
            _Pragma("unroll") for (int d0 = 0; d0 < 8; ++d0) wfb[B][d0] = *(const bf16x8*)(wp + d0 * 512); \
            astg = *(const uint4*)(arow + (size_t)(l) * PLD); asm volatile("" ::: "memory"); __builtin_amdgcn_sched_barrier(0); } while (0)
#define CMP_STAGE(B) do { u4 sv_ = {astg.x, astg.y, astg.z, astg.w}; *(LAS u4*)(afL + (B) * 4352 + sr_ * 136 + sc_) = sv_; } while (0)
#define CMP_MMA(B) do { _Pragma("unroll") for (int d0 = 0; d0 < 8; ++d0) { const bf16x8 af = *(const LAS bf16x8*)(afL + (B) * 4352 + r32 * 136 + d0 * 16 + hi * 8); \
            acc = __builtin_amdgcn_mfma_f32_32x32x16_bf16(wfb[B][d0], af, acc, 0, 0, 0); } } while (0)
        CMP_LOAD(0, 0); CMP_STAGE(0); __syncthreads();
#pragma unroll 1
        for (int l = 0; l < 32; l += 2) {
            CMP_LOAD(1, l + 1); CMP_MMA(0); CMP_STAGE(1); __syncthreads();
            if (l + 2 < 32) CMP_LOAD(0, l + 2);
            CMP_MMA(1); if (l + 2 < 32) CMP_STAGE(0); __syncthreads();
        }
#undef CMP_LOAD
#undef CMP_STAGE
#undef CMP_MMA
#pragma unroll
        for (int a = 0; a < 4; ++a) { const int h0 = wv * 32 + 8 * a + 4 * hi; const f4 pb = *(const f4*)(peb + kv * 256 + h0);
            uint2 o; o.x = pk_bf16(gelu_exact(acc[4 * a] + pb[0]), gelu_exact(acc[4 * a + 1] + pb[1])); o.y = pk_bf16(gelu_exact(acc[4 * a + 2] + pb[2]), gelu_exact(acc[4 * a + 3] + pb[3]));
            u2 ov = {o.x, o.y}; *(LAS u2*)(hidL + r32 * 264 + h0) = ov; }
        __syncthreads();
        f32x16 o2 = {};
        if (wv < 4) {
            const bf16_t* w2row = W2T + ((size_t)kv * 128 + wv * 32 + r32) * 256 + hi * 8;
#pragma unroll
            for (int k0 = 0; k0 < 16; ++k0) { const bf16x8 wf = *(const bf16x8*)(w2row + k0 * 16); const bf16x8 hf = *(const LAS bf16x8*)(hidL + r32 * 264 + k0 * 16 + hi * 8);
                o2 = __builtin_amdgcn_mfma_f32_32x32x16_bf16(wf, hf, o2, 0, 0, 0); }
            if (kv == 0) { float ss = 0.f;
#pragma unroll
                for (int r = 0; r < 16; ++r) ss += o2[r] * o2[r];
                ss += __shfl_xor(ss, 32); if (hi == 0) ssL[wv * 32 + r32] = ss; }
        }
        __syncthreads();
        if (wv < 4) {
            float rstd = 1.f;
            if (kv == 0) rstd = rsqrtf((ssL[r32] + ssL[32 + r32] + ssL[64 + r32] + ssL[96 + r32]) * (1.0f / 128.f) + 1e-6f);
            bf16_t* dst = (kv == 0 ? CMPK : CMPV) + (((size_t)b * 4 + g) * 128 + n) * 128;
#pragma unroll
            for (int a = 0; a < 4; ++a) { const int d0 = wv * 32 + 8 * a + 4 * hi; f4 gg = {1.f, 1.f, 1.f, 1.f}; if (kv == 0) gg = *(const f4*)(k_norm_g + d0);
                uint2 o; o.x = pk_bf16(o2[4 * a] * rstd * gg[0], o2[4 * a + 1] * rstd * gg[1]); o.y = pk_bf16(o2[4 * a + 2] * rstd * gg[2], o2[4 * a + 3] * rstd * gg[3]);
                if (n >= NCMP) { o.x = 0u; o.y = 0u; }
                *(uint2*)(dst + d0) = o; }
        }
        __syncthreads();
    }
}
__device__ __forceinline__ void p3_pool(const bf16_t* PROJ, const bf16_t* WPF, const float* pool_scale, bf16_t* MIX, LAS unsigned char* lds, int blk, int nblk) {
    const int tid = threadIdx.x, wv = __builtin_amdgcn_readfirstlane(tid >> 6), lane = tid & 63, r32 = lane & 31, hi = lane >> 5;
    LAS bf16_t* dL = (LAS bf16_t*)(lds + 40960);
    for (int it = 0; it < 4; ++it) {
        const int item = blk * 4 + it; if (item >= 1024) break;
        const int gi = item & 3, tt = item >> 2, tok0 = tt * 64, w = 2 << gi;
        { const int tg = tid >> 5, c0 = (tid & 31) * 8; const int tokA = tok0 + tg * 4, tA = tokA % NT;
          float rv[19][8];
#pragma unroll
          for (int q = 0; q < 19; ++q) { const int rel = q - 15;
              uint4 u = make_uint4(0u, 0u, 0u, 0u);
              if (rel >= 1 - w && tA + rel >= 0) u = *(const uint4*)(PROJ + (size_t)(tokA + rel) * PLD + gi * 256 + c0);
              const unsigned uu[4] = {u.x, u.y, u.z, u.w};
#pragma unroll
              for (int e = 0; e < 4; ++e) { rv[q][2 * e] = __uint_as_float(uu[e] << 16); rv[q][2 * e + 1] = __uint_as_float(uu[e] & 0xffff0000u); } }
#pragma unroll
          for (int i = 0; i < 4; ++i) { const int t = tA + i; const int nw = (t + 1 < w) ? t + 1 : w; const float rn = 1.0f / (float)nw;
              float s[8];
#pragma unroll
              for (int e = 0; e < 8; ++e) s[e] = 0.f;
#pragma unroll
              for (int q = 0; q < 16; ++q) { if (q < w) {
#pragma unroll
                  for (int e = 0; e < 8; ++e) s[e] += rv[15 + i - q][e]; } }
              u4 ov; ov[0] = pk_bf16(s[0] * rn - rv[15 + i][0], s[1] * rn - rv[15 + i][1]); ov[1] = pk_bf16(s[2] * rn - rv[15 + i][2], s[3] * rn - rv[15 + i][3]);
              ov[2] = pk_bf16(s[4] * rn - rv[15 + i][4], s[5] * rn - rv[15 + i][5]); ov[3] = pk_bf16(s[6] * rn - rv[15 + i][6], s[7] * rn - rv[15 + i][7]);
              *(LAS u4*)(dL + (tg * 4 + i) * 264 + c0) = ov; } }
        __syncthreads();
        const bf16_t* wfr = WPF + ((size_t)(gi * 8 + wv) * 16) * 512 + lane * 8;
        f32x16 a0 = {}, a1 = {};
#pragma unroll
        for (int k0 = 0; k0 < 16; ++k0) { const bf16x8 wf = *(const bf16x8*)(wfr + k0 * 512);
            const bf16x8 d0 = *(const LAS bf16x8*)(dL + r32 * 264 + k0 * 16 + hi * 8), d1 = *(const LAS bf16x8*)(dL + (32 + r32) * 264 + k0 * 16 + hi * 8);
            a0 = __builtin_amdgcn_mfma_f32_32x32x16_bf16(wf, d0, a0, 0, 0, 0); a1 = __builtin_amdgcn_mfma_f32_32x32x16_bf16(wf, d1, a1, 0, 0, 0); }
#pragma unroll
        for (int a = 0; a < 4; ++a) { const int dout = gi * 256 + wv * 32 + 8 * a + 4 * hi; const f4 ps = *(const f4*)(pool_scale + dout);
            uint2 o; o.x = pk_bf16(a0[4 * a] * ps[0], a0[4 * a + 1] * ps[1]); o.y = pk_bf16(a0[4 * a + 2] * ps[2], a0[4 * a + 3] * ps[3]);
            *(uint2*)(MIX + (size_t)(tok0 + r32) * DM + dout) = o;
            o.x = pk_bf16(a1[4 * a] * ps[0], a1[4 * a + 1] * ps[1]); o.y = pk_bf16(a1[4 * a + 2] * ps[2], a1[4 * a + 3] * ps[3]);
            *(uint2*)(MIX + (size_t)(tok0 + 32 + r32) * DM + dout) = o; }
        __syncthreads();
    }
}
}
namespace att {
constexpr int D = 128, KVBLK = 64, QBLK = 32, SHM_V = KVBLK * D * 2, SHM_K = KVBLK * D * 2; constexpr float SCALE = 0.08838834764831845f, THR = 8.f; constexpr bool WSKIP = true;
typedef short s16x4 __attribute__((ext_vector_type(4))); typedef float f32x4 __attribute__((ext_vector_type(4))); typedef unsigned u32x4 __attribute__((ext_vector_type(4)));
#define KSWZ(row, colB) ((row) * 256 + ((colB) ^ (((row) & 7) << 4)))
#define SBAR() __builtin_amdgcn_sched_barrier(0)
__device__ __forceinline__ int v_st(int k, int c) { const int kk = (k & ~0xC) | ((k & 4) << 1) | ((k & 8) >> 1); return ((kk >> 3) * 4 + (c >> 5)) * 512 + ((kk & 7) * 32 + (c & 31)) * 2; }
__device__ __forceinline__ int v_rd_base(int lane) { return ((lane & 3) << 3) | (((lane >> 2) & 3) << 6) | (((lane >> 4) & 1) << 5) | (((lane >> 5) & 1) << 8); }
constexpr int v_rd_off(int d0, int ks, int half) { return d0 * 512 + ks * 4096 + half * 2048; }
__device__ __forceinline__ int crow(int r, int hi) { return (r & 3) + 8 * (r >> 2) + 4 * hi; }
__device__ __forceinline__ unsigned cvtpk(float lo, float hi) {
    unsigned r; asm volatile("v_cvt_pk_bf16_f32 %0, %1, %2" : "=v"(r) : "v"(lo), "v"(hi)); return r;
}
__device__ __forceinline__ bf16x8 pack8(f32x4 a, f32x4 b) {
    u32x4 w = {cvtpk(a[0], a[1]), cvtpk(a[2], a[3]), cvtpk(b[0], b[1]), cvtpk(b[2], b[3])};
    return *reinterpret_cast<bf16x8*>(&w);
}
__device__ __forceinline__ void mask_tile(f32x16& p0, f32x16& p1, int dq, unsigned W) {
    const float NEG = -__builtin_inff();
#pragma unroll
    for (int r = 0; r < 16; ++r) {
        const int c = (r & 3) + 8 * (r >> 2);
        if ((unsigned)(dq - c) >= W) p0[r] = NEG;
        if ((unsigned)(dq - c - 32) >= W) p1[r] = NEG;
    }
}
__device__ __forceinline__ void partialSM(f32x16& p0, f32x16& p1, float& m_reg, float& mn, float& alpha) {
    float pmax = p0[0]; for (int r = 1; r < 16; ++r) pmax = fmaxf(pmax, p0[r]); for (int r = 0; r < 16; ++r) pmax = fmaxf(pmax, p1[r]);
    { auto rr = __builtin_amdgcn_permlane32_swap(__float_as_uint(pmax), __float_as_uint(pmax), false, false);
      pmax = fmaxf(__uint_as_float(rr[0]), __uint_as_float(rr[1])); }
    constexpr float C2 = 1.4426950408889634f * SCALE;
    if (__builtin_expect(__all((pmax - m_reg) * SCALE <= THR), 1)) { mn = m_reg; alpha = 1.f; }
    else { mn = fmaxf(m_reg, pmax); alpha = __builtin_amdgcn_exp2f((m_reg - mn) * C2); m_reg = mn; }
    const float mnL = -mn * C2;
    for (int r = 0; r < 16; ++r) p0[r] = fmaf(p0[r], C2, mnL); for (int r = 0; r < 16; ++r) p1[r] = fmaf(p1[r], C2, mnL);
    for (int r = 0; r < 16; ++r) p0[r] = __builtin_amdgcn_exp2f(p0[r]);
}
__device__ __forceinline__ void finishSM(f32x16& p0, f32x16& p1, float alpha, float& l_reg, bf16x8& pa0, bf16x8& pa1, bf16x8& pa2, bf16x8& pa3) {
    for (int r = 0; r < 16; ++r) p1[r] = __builtin_amdgcn_exp2f(p1[r]);
    float ps = 0; for (int r = 0; r < 16; ++r) ps += p0[r]; for (int r = 0; r < 16; ++r) ps += p1[r];
    { auto rr = __builtin_amdgcn_permlane32_swap(__float_as_uint(ps), __float_as_uint(ps), false, false);
      ps = __uint_as_float(rr[0]) + __uint_as_float(rr[1]); }
    l_reg = l_reg * alpha + ps;
#define PK4(P, B_, OUT) do { unsigned a0 = cvtpk(P[B_+0], P[B_+1]), a1 = cvtpk(P[B_+2], P[B_+3]);                          \
        unsigned b0 = cvtpk(P[B_+4], P[B_+5]), b1 = cvtpk(P[B_+6], P[B_+7]);                                             \
        auto r0 = __builtin_amdgcn_permlane32_swap(a0, b0, false, false); auto r1 = __builtin_amdgcn_permlane32_swap(a1, b1, false, false); \
        u32x4 w = {r0[0], r1[0], r0[1], r1[1]}; OUT = *reinterpret_cast<bf16x8*>(&w); } while (0)
    PK4(p0, 0, pa0); PK4(p0, 8, pa1); PK4(p1, 0, pa2); PK4(p1, 8, pa3);
#undef PK4
}
template <int KB, bool SK>
__device__ __forceinline__ void qkt(f32x16& p0, f32x16& p1, const char* K_lds, int r32, int hi, const bf16x8* qr, bool act) {
    if (SK && !act) { const float NEG = -__builtin_inff();
#pragma unroll
        for (int r = 0; r < 16; ++r) { p0[r] = NEG; p1[r] = NEG; } return; }
    p0 = f32x16{}; p1 = f32x16{};
    const char* kb[4];
#pragma unroll
    for (int dd = 0; dd < 4; ++dd) kb[dd] = K_lds + KB * SHM_K + KSWZ(r32, (dd * 16 + hi * 8) * 2);
#pragma unroll
    for (int d0 = 0; d0 < 8; ++d0) { const char* a = kb[d0 & 3] + (d0 >> 2) * 128;
        bf16x8 b0 = *reinterpret_cast<const bf16x8*>(a);
        bf16x8 b1 = *reinterpret_cast<const bf16x8*>(a + 32 * 256);
        p0 = __builtin_amdgcn_mfma_f32_32x32x16_bf16(b0, qr[d0], p0, 0, 0, 0);
        p1 = __builtin_amdgcn_mfma_f32_32x32x16_bf16(b1, qr[d0], p1, 0, 0, 0); }
}
template <int VB, bool SK>
__device__ __forceinline__ void pv_tile(f32x16* o, int vb0, bf16x8 pa0, bf16x8 pa1, bf16x8 pa2, bf16x8 pa3, bool act) {
    if (SK && !act) return;
#define TRRD(dst, off) asm volatile("ds_read_b64_tr_b16 %0, %1 offset:%2" : "=&v"(dst) : "v"(vb0), "i"(off) : "memory")
#define PV_D0(d0) do { s16x4 l0, l1, l2, l3, h0, h1, h2, h3; constexpr int b_ = VB * SHM_V + v_rd_off(d0, 0, 0);     \
        TRRD(l0, b_); TRRD(h0, b_ + 2048); TRRD(l1, b_ + 4096); TRRD(h1, b_ + 6144); TRRD(l2, b_ + 8192); TRRD(h2, b_ + 10240); TRRD(l3, b_ + 12288); TRRD(h3, b_ + 14336); \
        asm volatile("s_waitcnt lgkmcnt(0)" ::: "memory"); SBAR();                 \
        o[d0] = __builtin_amdgcn_mfma_f32_32x32x16_bf16(pa0, (bf16x8){l0[0], l0[1], l0[2], l0[3], h0[0], h0[1], h0[2], h0[3]}, o[d0], 0, 0, 0);   \
        o[d0] = __builtin_amdgcn_mfma_f32_32x32x16_bf16(pa1, (bf16x8){l1[0], l1[1], l1[2], l1[3], h1[0], h1[1], h1[2], h1[3]}, o[d0], 0, 0, 0);   \
        o[d0] = __builtin_amdgcn_mfma_f32_32x32x16_bf16(pa2, (bf16x8){l2[0], l2[1], l2[2], l2[3], h2[0], h2[1], h2[2], h2[3]}, o[d0], 0, 0, 0);   \
        o[d0] = __builtin_amdgcn_mfma_f32_32x32x16_bf16(pa3, (bf16x8){l3[0], l3[1], l3[2], l3[3], h3[0], h3[1], h3[2], h3[3]}, o[d0], 0, 0, 0); } while (0)
    PV_D0(0); PV_D0(1); PV_D0(2); PV_D0(3);
#undef PV_D0
#undef TRRD
}
template <int VB, bool SK>
__device__ __forceinline__ void pv_tile_p(f32x16* o, int vb0, bf16x8 pa0, bf16x8 pa1, bf16x8 pa2, bf16x8 pa3, bool act) {
    if (SK && !act) return;
#define TRRD(dst, off) asm volatile("ds_read_b64_tr_b16 %0, %1 offset:%2" : "=&v"(dst) : "v"(vb0), "i"(off) : "memory")
#define PV_RD(X, d0) do { constexpr int b_ = VB * SHM_V + v_rd_off(d0, 0, 0); \
        TRRD(X##l0, b_); TRRD(X##h0, b_ + 2048); TRRD(X##l1, b_ + 4096); TRRD(X##h1, b_ + 6144); TRRD(X##l2, b_ + 8192); TRRD(X##h2, b_ + 10240); TRRD(X##l3, b_ + 12288); TRRD(X##h3, b_ + 14336); } while (0)
#define PV_MM(X, d0) do { \
        o[d0] = __builtin_amdgcn_mfma_f32_32x32x16_bf16(pa0, (bf16x8){X##l0[0], X##l0[1], X##l0[2], X##l0[3], X##h0[0], X##h0[1], X##h0[2], X##h0[3]}, o[d0], 0, 0, 0);   \
        o[d0] = __builtin_amdgcn_mfma_f32_32x32x16_bf16(pa1, (bf16x8){X##l1[0], X##l1[1], X##l1[2], X##l1[3], X##h1[0], X##h1[1], X##h1[2], X##h1[3]}, o[d0], 0, 0, 0);   \
        o[d0] = __builtin_amdgcn_mfma_f32_32x32x16_bf16(pa2, (bf16x8){X##l2[0], X##l2[1], X##l2[2], X##l2[3], X##h2[0], X##h2[1], X##h2[2], X##h2[3]}, o[d0], 0, 0, 0);   \
        o[d0] = __builtin_amdgcn_mfma_f32_32x32x16_bf16(pa3, (bf16x8){X##l3[0], X##l3[1], X##l3[2], X##l3[3], X##h3[0], X##h3[1], X##h3[2], X##h3[3]}, o[d0], 0, 0, 0); } while (0)
    s16x4 Al0, Al1, Al2, Al3, Ah0, Ah1, Ah2, Ah3, Bl0, Bl1, Bl2, Bl3, Bh0, Bh1, Bh2, Bh3;
    PV_RD(A, 0); PV_RD(B, 1);
    asm volatile("s_waitcnt lgkmcnt(8)" ::: "memory"); SBAR(); PV_MM(A, 0); SBAR();
    PV_RD(A, 2);
    asm volatile("s_waitcnt lgkmcnt(8)" ::: "memory"); SBAR(); PV_MM(B, 1); SBAR();
    PV_RD(B, 3);
    asm volatile("s_waitcnt lgkmcnt(8)" ::: "memory"); SBAR(); PV_MM(A, 2); SBAR();
    asm volatile("s_waitcnt lgkmcnt(0)" ::: "memory"); SBAR(); PV_MM(B, 3);
#undef PV_MM
#undef PV_RD
#undef TRRD
}
template <int KB>
__device__ __forceinline__ void qkt_p(f32x16& p0, f32x16& p1, const char* K_lds, int r32, int hi, const bf16x8* qr) {
    p0 = f32x16{}; p1 = f32x16{};
    const char* kb[4];
#pragma unroll
    for (int dd = 0; dd < 4; ++dd) kb[dd] = K_lds + KB * SHM_K + KSWZ(r32, (dd * 16 + hi * 8) * 2);
#define QK_RD(X, g) do { _Pragma("unroll") for (int e = 0; e < 2; ++e) { const int d0 = (g) * 2 + e; const char* a = kb[d0 & 3] + (d0 >> 2) * 128; \
        X##0[e] = *reinterpret_cast<const bf16x8*>(a); X##1[e] = *reinterpret_cast<const bf16x8*>(a + 32 * 256); } } while (0)
#define QK_MM(X, g) do { _Pragma("unroll") for (int e = 0; e < 2; ++e) { const int d0 = (g) * 2 + e; \
        p0 = __builtin_amdgcn_mfma_f32_32x32x16_bf16(X##0[e], qr[d0], p0, 0, 0, 0); p1 = __builtin_amdgcn_mfma_f32_32x32x16_bf16(X##1[e], qr[d0], p1, 0, 0, 0); } } while (0)
    bf16x8 X0[2], X1[2], Y0[2], Y1[2];
    QK_RD(X, 0); QK_RD(Y, 1); SBAR();
    QK_MM(X, 0); SBAR(); QK_RD(X, 2); SBAR();
    QK_MM(Y, 1); SBAR(); QK_RD(Y, 3); SBAR();
    QK_MM(X, 2); SBAR(); QK_MM(Y, 3);
#undef QK_RD
#undef QK_MM
}
}
#ifndef MK_BR_MASK
#define MK_BR_MASK 7
#endif
#define BRM_C ((MK_BR_MASK & 1) ? 1.f : 0.f)
#define BRM_S ((MK_BR_MASK & 2) ? 1.f : 0.f)
#define BRM_W ((MK_BR_MASK & 4) ? 1.f : 0.f)
namespace {
using att::crow; using att::SHM_K; using att::SHM_V;
struct KVStage { bf16x8 k0, k1, v0, v1; };
__device__ __forceinline__ void kv_load(KVStage& S, const bf16_t* K, int kstride, const bf16_t* V, int vstride, int kb, int sr, int sc) {
    const bf16_t* kt = K + (size_t)kb * kstride; const bf16_t* vt = V + (size_t)kb * vstride;
    const unsigned ko = (unsigned)(sr * kstride + sc), vo = (unsigned)(sr * vstride + sc);
    S.k0 = *(const bf16x8*)(kt + ko); S.k1 = *(const bf16x8*)(kt + (ko + 32u * (unsigned)kstride));
    S.v0 = *(const bf16x8*)(vt + vo); S.v1 = *(const bf16x8*)(vt + (vo + 32u * (unsigned)vstride));
}
template <int BUF> __device__ __forceinline__ void kv_write(const KVStage& S, LAS unsigned char* V_lds, LAS unsigned char* K_lds, int kws, int vst0, int vst1) {
    *(LAS bf16x8*)(K_lds + BUF * SHM_K + kws) = S.k0; *(LAS bf16x8*)(K_lds + BUF * SHM_K + kws + 32 * 256) = S.k1;
    *(LAS bf16x8*)(V_lds + BUF * SHM_V + vst0) = S.v0; *(LAS bf16x8*)(V_lds + BUF * SHM_V + vst1) = S.v1;
}
__device__ __forceinline__ void pack_P(const f32x16& p0, const f32x16& p1, bf16x8& pa0, bf16x8& pa1, bf16x8& pa2, bf16x8& pa3) {
#define PK4(P, B_, OUT) do { unsigned a0 = att::cvtpk(P[B_+0], P[B_+1]), a1 = att::cvtpk(P[B_+2], P[B_+3]); unsigned b0 = att::cvtpk(P[B_+4], P[B_+5]), b1 = att::cvtpk(P[B_+6], P[B_+7]); \
        auto r0 = __builtin_amdgcn_permlane32_swap(a0, b0, false, false); auto r1 = __builtin_amdgcn_permlane32_swap(a1, b1, false, false); \
        att::u32x4 w = {r0[0], r1[0], r0[1], r1[1]}; OUT = *reinterpret_cast<bf16x8*>(&w); } while (0)
    PK4(p0, 0, pa0); PK4(p0, 8, pa1); PK4(p1, 0, pa2); PK4(p1, 8, pa3);
#undef PK4
}
__device__ __forceinline__ void load_q_raw(uint4 (&raw)[8], const bf16_t* PROJ, int tok, int hq, int hi) {
    const bf16_t* qp = PROJ + (size_t)tok * PLD + QOFF + hq * 128 + hi * 8;
#pragma unroll
    for (int d0 = 0; d0 < 8; ++d0) raw[d0] = *(const uint4*)(qp + d0 * 16);
}
template <bool ROPE> __device__ __forceinline__ void finish_q(bf16x8 (&qf)[8], const uint4 (&raw)[8], int t, int hi, const float* q_norm_g, const float* rope) {
    float ss = 0.f;
#pragma unroll
    for (int d0 = 0; d0 < 8; ++d0) { const unsigned uu[4] = {raw[d0].x, raw[d0].y, raw[d0].z, raw[d0].w};
#pragma unroll
        for (int e = 0; e < 4; ++e) { const float lo = __uint_as_float(uu[e] << 16), h2 = __uint_as_float(uu[e] & 0xffff0000u); ss += lo * lo + h2 * h2; } }
    ss += __shfl_xor(ss, 32);
    const float rstd = rsqrtf(ss * (1.0f / 128.f) + 1e-6f);
#pragma unroll
    for (int d0 = 0; d0 < 4; ++d0) {
        float ya[8], yb[8];
        { const unsigned ua[4] = {raw[d0].x, raw[d0].y, raw[d0].z, raw[d0].w}, ub[4] = {raw[d0 + 4].x, raw[d0 + 4].y, raw[d0 + 4].z, raw[d0 + 4].w};
          const float* gp = q_norm_g + d0 * 16 + hi * 8; const f4 ga0 = *(const f4*)gp, ga1 = *(const f4*)(gp + 4), gb0 = *(const f4*)(gp + 64), gb1 = *(const f4*)(gp + 68);
#pragma unroll
          for (int e = 0; e < 4; ++e) { const float g_a0 = e < 2 ? ga0[2 * e] : ga1[2 * e - 4], g_a1 = e < 2 ? ga0[2 * e + 1] : ga1[2 * e - 3], g_b0 = e < 2 ? gb0[2 * e] : gb1[2 * e - 4], g_b1 = e < 2 ? gb0[2 * e + 1] : gb1[2 * e - 3];
              ya[2 * e] = __uint_as_float(ua[e] << 16) * rstd * g_a0; ya[2 * e + 1] = __uint_as_float(ua[e] & 0xffff0000u) * rstd * g_a1;
              yb[2 * e] = __uint_as_float(ub[e] << 16) * rstd * g_b0; yb[2 * e + 1] = __uint_as_float(ub[e] & 0xffff0000u) * rstd * g_b1; } }
        if (ROPE) { const float* cp = rope + t * 64 + d0 * 16 + hi * 8; const float* sp = cp + NT * 64;
            const f4 c0 = *(const f4*)cp, c1 = *(const f4*)(cp + 4), s0 = *(const f4*)sp, s1 = *(const f4*)(sp + 4);
#pragma unroll
            for (int e = 0; e < 8; ++e) { const float cs = e < 4 ? c0[e & 3] : c1[e & 3], sn = e < 4 ? s0[e & 3] : s1[e & 3]; const float a = ya[e], b = yb[e]; ya[e] = a * cs - b * sn; yb[e] = b * cs + a * sn; } }
        { att::u32x4 w = {att::cvtpk(ya[0], ya[1]), att::cvtpk(ya[2], ya[3]), att::cvtpk(ya[4], ya[5]), att::cvtpk(ya[6], ya[7])}; qf[d0] = *reinterpret_cast<bf16x8*>(&w); }
        { att::u32x4 w = {att::cvtpk(yb[0], yb[1]), att::cvtpk(yb[2], yb[3]), att::cvtpk(yb[4], yb[5]), att::cvtpk(yb[6], yb[7])}; qf[d0 + 4] = *reinterpret_cast<bf16x8*>(&w); }
        __builtin_amdgcn_sched_barrier(0);
    }
}

template <bool ROPE> __device__ __forceinline__ void load_q(bf16x8 (&qf)[8], const bf16_t* PROJ, int tok, int t, int hq, int hi, const float* q_norm_g, const float* rope) {
    uint4 raw[8]; load_q_raw(raw, PROJ, tok, hq, hi); finish_q<ROPE>(qf, raw, t, hi, q_norm_g, rope);
}

__device__ __forceinline__ void p4a_cmp(const bf16_t* PROJ, const bf16_t* CMPK, const bf16_t* CMPV, const float* q_norm_g, bf16_t* OC, unsigned* SELM, LAS unsigned char* lds, int blk, int nblk) {
    const int tid = threadIdx.x, wid = __builtin_amdgcn_readfirstlane(tid >> 6), lane = tid & 63, r32 = lane & 31, hi = lane >> 5;
    LAS unsigned char* V_lds = lds; LAS unsigned char* K_lds = lds + 2 * SHM_V;
    LAS float* wsf = (LAS float*)(lds + 2 * SHM_V + 2 * SHM_K) + wid * 64;
    const int sr = tid >> 4, sc = (tid & 15) * 8, vst0 = att::v_st(sr, sc), vst1 = att::v_st(32 + sr, sc), kws = KSWZ(sr, sc * 2);
    const int vb0 = (int)(size_t)V_lds + att::v_rd_base(lane);
    for (int item = blk; item < 256; item += nblk) {
        const int tb = item & 7, g = (item >> 3) & 3, b = item >> 5;
        const bf16_t* Kc = CMPK + ((size_t)b * 4 + g) * 128 * 128; const bf16_t* Vc = CMPV + ((size_t)b * 4 + g) * 128 * 128;
        { KVStage S; kv_load(S, Kc, 128, Vc, 128, 0, sr, sc); kv_write<0>(S, V_lds, K_lds, kws, vst0, vst1); kv_load(S, Kc, 128, Vc, 128, 64, sr, sc); kv_write<1>(S, V_lds, K_lds, kws, vst0, vst1); }
        __syncthreads();
        const int t = tb * 256 + wid * 32 + r32, tok = b * NT + t;
        const int nv = t >= 31 ? ((t - 31) / 16 + 1 > NCMP ? NCMP : (t - 31) / 16 + 1) : 0;
        float impA[16];
#pragma unroll
        for (int i = 0; i < 16; ++i) impA[i] = 0.f;
#pragma unroll 1
        for (int r6 = 0; r6 < 6; ++r6) {
            const int hq = g * 6 + r6;
            bf16x8 qf[8]; load_q<false>(qf, PROJ, tok, t, hq, hi, q_norm_g, nullptr);
            f32x16 P[2][2];
            att::qkt<0, false>(P[0][0], P[0][1], (const char*)K_lds, r32, hi, qf, true);
            att::qkt<1, false>(P[1][0], P[1][1], (const char*)K_lds, r32, hi, qf, true);
            float mx = -INFINITY;
#pragma unroll
            for (int T = 0; T < 2; ++T)
#pragma unroll
                for (int hf = 0; hf < 2; ++hf)
#pragma unroll
                    for (int r = 0; r < 16; ++r) { const int n = T * 64 + hf * 32 + (r & 3) + 8 * (r >> 2) + 4 * hi; const float s = (n < nv) ? P[T][hf][r] * SCALE : -INFINITY; P[T][hf][r] = s; mx = fmaxf(mx, s); }
            mx = fmaxf(mx, __shfl_xor(mx, 32)); if (!(mx > -INFINITY)) mx = 0.f;
            float sum = 0.f;
#pragma unroll
            for (int T = 0; T < 2; ++T)
#pragma unroll
                for (int hf = 0; hf < 2; ++hf)
#pragma unroll
                    for (int r = 0; r < 16; ++r) { const float p = __expf(P[T][hf][r] - mx); P[T][hf][r] = p; sum += p; }
            sum += __shfl_xor(sum, 32);
            const float gc = sigmoidf_(bf2f(PROJ[(size_t)tok * PLD + GOFF + hq * 3 + 0]));
            const float inv = sum > 0.f ? 1.0f / sum : 0.f;
            float bv[16];
            bf16x8 pa[2][4];
#pragma unroll
            for (int T = 0; T < 2; ++T) {
#pragma unroll
                for (int hf = 0; hf < 2; ++hf)
#pragma unroll
                    for (int a = 0; a < 4; ++a) { const float p0 = P[T][hf][4 * a], p1 = P[T][hf][4 * a + 1], p2 = P[T][hf][4 * a + 2], p3 = P[T][hf][4 * a + 3];
                        impA[(T * 2 + hf) * 4 + a] += ((p0 + p1) + (p2 + 0.5f * p3)) * inv; bv[(T * 2 + hf) * 4 + a] = 0.5f * p3 * inv; }
                pack_P(P[T][0], P[T][1], pa[T][0], pa[T][1], pa[T][2], pa[T][3]);
            }
            { float prev = 0.f;
#pragma unroll
              for (int i = 0; i < 16; ++i) { const float bp = __shfl_xor(bv[i], 32); impA[i] += hi ? bp : prev; prev = bp; } }
            asm volatile("" ::: "memory"); __builtin_amdgcn_sched_barrier(0);
            f32x16 o[4] = {};
            att::pv_tile<0, false>(o, vb0, pa[0][0], pa[0][1], pa[0][2], pa[0][3], true);
            att::pv_tile<1, false>(o, vb0, pa[1][0], pa[1][1], pa[1][2], pa[1][3], true);
            if (hi == 0) wsf[r32] = gc * inv * BRM_C;
            asm volatile("s_waitcnt lgkmcnt(0)" ::: "memory");
            bf16_t* Ow = OC + (size_t)(b * NT + tb * 256 + wid * 32) * 3072 + hq * 128; asm volatile("" : "+v"(Ow));
#pragma unroll
            for (int r = 0; r < 16; ++r) { int hl = hi; asm volatile("" : "+v"(hl)); const int orow = crow(r, hl); const float f = wsf[orow];
#pragma unroll
                for (int d0 = 0; d0 < 4; ++d0) Ow[(size_t)orow * 3072 + d0 * 32 + r32] = (bf16_t)(att::cvtpk(o[d0][r] * f, 0.f) & 0xffffu);
                if ((r & 3) == 3) __builtin_amdgcn_sched_barrier(0); }
            asm volatile("s_waitcnt lgkmcnt(0)" ::: "memory");
        }
        float imp[32];
#pragma unroll
        for (int i = 0; i < 16; ++i) { const float oth = __shfl_xor(impA[i], 32); imp[2 * i] = hi ? oth : impA[i]; imp[2 * i + 1] = hi ? impA[i] : oth; }
        const int cur = t >> 6;
        int ka[16], kb2[16];
#pragma unroll
        for (int j = 0; j < 32; ++j) { const bool forced = (j == 0) || (j == cur) || (j == cur - 1); const bool valid = (j * 64) <= t;
            const float scv = valid ? imp[j] + (forced ? 1000.f : 0.f) : -1e9f; const int key = (f2key(scv) & ~31) | (31 - j);
            if (j < 16) ka[j] = key; else kb2[j - 16] = key; }
        sort16_desc(ka); sort16_desc(kb2);
        unsigned mask = 0u;
#pragma unroll
        for (int i = 0; i < 16; ++i) { const int m = max(ka[i], kb2[15 - i]); mask |= 1u << (31 - (m & 31)); }
        if (hi == 0) SELM[(size_t)tok * 4 + g] = mask;
        __syncthreads();
    }
}
}
namespace {
template <bool SEL>
__device__ __forceinline__ void attn_branch(f32x16 (&o)[4], float& l_out, const bf16x8 (&qf)[8], KVStage& S, const bf16_t* K, const bf16_t* V, int j_lo, int j_hi, const bf16_t* nK, const bf16_t* nV, int n_jlo, int qlo, int qm, unsigned selm,
                                            LAS unsigned char* V_lds, LAS unsigned char* K_lds, LAS float* al_l, int vb0, int sr, int sc, int kws, int vst0, int vst1, int r32, int hi) {
    constexpr int W = 512;
    float m_reg = -1e30f, l_reg = 0.f;
#pragma unroll
    for (int d = 0; d < 4; ++d) o[d] = f32x16{};
    kv_write<0>(S, V_lds, K_lds, kws, vst0, vst1);
    __syncthreads();
#define ATT_TILE(BUF, tj) do { const int kb_ = (tj) * 64; const bool more_ = (tj) + 1 < j_hi; \
        if (more_) kv_load(S, K, 128, V, PLD, kb_ + 64, sr, sc); else kv_load(S, nK, 128, nV, PLD, n_jlo * 64, sr, sc); \
        bool act_ = kb_ <= qlo + 31; \
        if (SEL) act_ = act_ && (__builtin_amdgcn_ballot_w64(((selm >> (tj)) & 1u) != 0u) != 0ull); else act_ = act_ && (kb_ + 63 >= qlo - W + 1); \
        if (act_) { f32x16 p0, p1; att::qkt_p<BUF>(p0, p1, (const char*)K_lds, r32, hi, qf); \
            if (SEL) { if (kb_ + 63 > qlo) att::mask_tile(p0, p1, qm - kb_, 0x7fffffffu); \
                       if (((selm >> (tj)) & 1u) == 0u) { _Pragma("unroll") for (int r = 0; r < 16; ++r) { p0[r] = -INFINITY; p1[r] = -INFINITY; } } } \
            else { if (kb_ + 63 > qlo || kb_ <= qlo + 31 - W) att::mask_tile(p0, p1, qm - kb_, (unsigned)W); } \
            float mn_, al_; att::partialSM(p0, p1, m_reg, mn_, al_); bf16x8 pa0, pa1, pa2, pa3; att::finishSM(p0, p1, al_, l_reg, pa0, pa1, pa2, pa3); \
            if (__any(al_ < 1.f)) { if (hi == 0) al_l[r32] = al_; asm volatile("s_waitcnt lgkmcnt(0)" ::: "memory"); \
                _Pragma("unroll") for (int d_ = 0; d_ < 4; ++d_) _Pragma("unroll") for (int r = 0; r < 16; ++r) o[d_][r] *= al_l[crow(r, hi)]; } \
            att::pv_tile_p<BUF, false>(o, vb0, pa0, pa1, pa2, pa3, true); } \
        if (more_) kv_write<1 - BUF>(S, V_lds, K_lds, kws, vst0, vst1); \
        __syncthreads(); } while (0)
#pragma unroll 1
    for (int tj = j_lo; tj < j_hi; tj += 2) {
        ATT_TILE(0, tj);
        if (tj + 1 < j_hi) ATT_TILE(1, tj + 1);
    }
#undef ATT_TILE
    l_out = l_reg;
}
__device__ __forceinline__ void p4b_attn(const bf16_t* PROJ, const bf16_t* KSEL, const bf16_t* KWIN, const unsigned* SELM, const bf16_t* OC, const float* rope, const float* q_norm_g, bf16_t* MIX,
                                         LAS unsigned char* lds, int blk, int nblk) {
    const int tid = threadIdx.x, wid = __builtin_amdgcn_readfirstlane(tid >> 6), lane = tid & 63, r32 = lane & 31, hi = lane >> 5;
    LAS unsigned char* V_lds = lds; LAS unsigned char* K_lds = lds + 2 * SHM_V;
    LAS float* wsf = (LAS float*)(lds + 2 * SHM_V + 2 * SHM_K) + wid * 64;
    LAS bf16_t* ost = (LAS bf16_t*)(lds + 2 * SHM_V + 2 * SHM_K + 2048) + wid * 32 * 136;
    const int sr = tid >> 4, sc = (tid & 15) * 8, vst0 = att::v_st(sr, sc), vst1 = att::v_st(32 + sr, sc), kws = KSWZ(sr, sc * 2);
    const int vb0 = (int)(size_t)V_lds + att::v_rd_base(lane);
#define P4B_ITEM(mm, qb_, b_, hq_) const int idx##mm = (mm) * 256 + (((mm) & 1) ? (nblk - 1 - blk) : blk); const int qb_ = 7 - idx##mm / 192, b_ = (idx##mm % 192) / 24, hq_ = (idx##mm % 192) % 24
#define P4B_KSEL(b_, hq_) (KSEL + ((size_t)(b_) * 4 + (hq_) / 6) * NT * 128)
#define P4B_VSEL(b_, hq_) (PROJ + (size_t)(b_) * NT * PLD + KVOFF + ((1 * 2 + 1) * 4 + (hq_) / 6) * 128)
    KVStage S;
    { P4B_ITEM(0, qb0, b0, hq0); (void)qb0; kv_load(S, P4B_KSEL(b0, hq0), 128, P4B_VSEL(b0, hq0), PLD, 0, sr, sc); }
#pragma unroll 1
    for (int m = 0; m < 6; ++m) {
        P4B_ITEM(m, qb, b, hq); const int g = hq / 6;
        const int mn = m + 1 < 6 ? m + 1 : m; P4B_ITEM(mn, qbn, bn, hqn); (void)qbn;
        const int P0 = qb * 256, qlo = P0 + wid * 32, t = qlo + r32, tok = b * NT + t, qm = t - 4 * hi;
        bf16x8 qf[8]; load_q<true>(qf, PROJ, tok, t, hq, hi, q_norm_g, rope);
        const unsigned selm = SELM[(size_t)tok * 4 + g];
        const float gs = sigmoidf_(bf2f(PROJ[(size_t)tok * PLD + GOFF + hq * 3 + 1])), gwv = sigmoidf_(bf2f(PROJ[(size_t)tok * PLD + GOFF + hq * 3 + 2]));
        const int j_hi = qb * 4 + 4;
        f32x16 o[4]; float lsum;
        const int jl = (P0 - 511 > 0) ? (P0 - 511) / 64 : 0;
        const bf16_t* Kw = KWIN + ((size_t)b * 4 + g) * NT * 128; const bf16_t* Vw = PROJ + (size_t)b * NT * PLD + KVOFF + ((2 * 2 + 1) * 4 + g) * 128;
        attn_branch<true>(o, lsum, qf, S, P4B_KSEL(b, hq), P4B_VSEL(b, hq), 0, j_hi, Kw, Vw, jl, qlo, qm, selm,
                          V_lds, K_lds, wsf + 32, vb0, sr, sc, kws, vst0, vst1, r32, hi);
        if (hi == 0) wsf[r32] = BRM_S * gs / lsum;
        asm volatile("s_waitcnt lgkmcnt(0)" ::: "memory");
#pragma unroll
        for (int r = 0; r < 16; ++r) { int hl = hi; asm volatile("" : "+v"(hl)); const int orow = crow(r, hl); const float f = wsf[orow];
#pragma unroll
            for (int d0 = 0; d0 < 4; ++d0) ost[orow * 136 + d0 * 32 + r32] = (bf16_t)(att::cvtpk(o[d0][r] * f, 0.f) & 0xffffu); }
        attn_branch<false>(o, lsum, qf, S, Kw, Vw, jl, j_hi, P4B_KSEL(bn, hqn), P4B_VSEL(bn, hqn), 0, qlo, qm, 0u,
                           V_lds, K_lds, wsf + 32, vb0, sr, sc, kws, vst0, vst1, r32, hi);
        if (hi == 0) wsf[r32] = BRM_W * gwv / lsum;
        asm volatile("s_waitcnt lgkmcnt(0)" ::: "memory");
#pragma unroll
        for (int r = 0; r < 16; ++r) { int hl = hi; asm volatile("" : "+v"(hl)); const int orow = crow(r, hl); const float f = wsf[orow];
#pragma unroll
            for (int d0 = 0; d0 < 4; ++d0) { LAS bf16_t* p = ost + orow * 136 + d0 * 32 + r32; *p = (bf16_t)(att::cvtpk(o[d0][r] * f + bf2f(*p), 0.f) & 0xffffu); } }
        asm volatile("s_waitcnt lgkmcnt(0)" ::: "memory");
        const size_t rowbase = (size_t)(b * NT + qlo);
#pragma unroll
        for (int i = 0; i < 8; ++i) { const int ch = i * 64 + lane, row = ch >> 4, c8 = (ch & 15) * 8;
            const u4 sv = *(const LAS u4*)(ost + row * 136 + c8); const uint4 cv = *(const uint4*)(OC + (rowbase + row) * 3072 + hq * 128 + c8);
            const unsigned s4[4] = {sv[0], sv[1], sv[2], sv[3]}, c4[4] = {cv.x, cv.y, cv.z, cv.w}; unsigned o4[4];
#pragma unroll
            for (int e = 0; e < 4; ++e) o4[e] = att::cvtpk(__uint_as_float(s4[e] << 16) + __uint_as_float(c4[e] << 16), __uint_as_float(s4[e] & 0xffff0000u) + __uint_as_float(c4[e] & 0xffff0000u));
            *(uint4*)(MIX + (rowbase + row) * DM + 1024 + hq * 128 + c8) = make_uint4(o4[0], o4[1], o4[2], o4[3]);
            if (i & 1) __builtin_amdgcn_sched_barrier(0); }
        __syncthreads();
    }
#undef P4B_ITEM
#undef P4B_KSEL
#undef P4B_VSEL
}
}
namespace {
typedef float f2v __attribute__((ext_vector_type(2)));
constexpr size_t WS_USC = WS_END_C;
constexpr size_t WS_VSC = WS_USC + 65536;
constexpr size_t WS_END_F = WS_VSC + 65536;
constexpr size_t PEER8_SLAB = (size_t)16384 * 128;

__device__ __forceinline__ unsigned pk4_fp8(float a, float b, float c, float d) { int p = __builtin_amdgcn_cvt_pk_fp8_f32(a, b, 0, false); p = __builtin_amdgcn_cvt_pk_fp8_f32(c, d, p, true); return (unsigned)p; }

__device__ __forceinline__ void p0_peer_cvt8(const float* src, unsigned char* dst, float* scale, int blk, int nblk) {
    const int tid = threadIdx.x, w = tid >> 6, lane = tid & 63, step = nblk * NWAVES;
    int e = blk * NWAVES + w; if (e >= 16384) return;
    float4 v[4][4];
#define CV_LOAD(X, ee) do { const float* r_ = src + (size_t)(ee) * DM + lane * 16; \
        _Pragma("unroll") for (int i = 0; i < 4; ++i) _Pragma("unroll") for (int q = 0; q < 4; ++q) X[i][q] = *(const float4*)(r_ + i * 1024 + q * 4); } while (0)
    CV_LOAD(v, e);
#pragma unroll 1
    for (; e < 16384; e += step) {
        float4 nv[4][4];
        const int en = e + step < 16384 ? e + step : e;
        CV_LOAD(nv, en);
        float m = 0.f;
#pragma unroll
        for (int i = 0; i < 4; ++i)
#pragma unroll
            for (int q = 0; q < 4; ++q) m = fmaxf(m, fmaxf(fmaxf(fabsf(v[i][q].x), fabsf(v[i][q].y)), fmaxf(fabsf(v[i][q].z), fabsf(v[i][q].w))));
        m = wave_max(m);
        const float inv = m > 0.f ? 448.0f / m : 1.0f;
        if (lane == 0) scale[e] = m > 0.f ? m * (1.0f / 448.0f) : 1.0f;
#pragma unroll
        for (int i = 0; i < 4; ++i) { uint4 o;
            o.x = pk4_fp8(v[i][0].x * inv, v[i][0].y * inv, v[i][0].z * inv, v[i][0].w * inv); o.y = pk4_fp8(v[i][1].x * inv, v[i][1].y * inv, v[i][1].z * inv, v[i][1].w * inv);
            o.z = pk4_fp8(v[i][2].x * inv, v[i][2].y * inv, v[i][2].z * inv, v[i][2].w * inv); o.w = pk4_fp8(v[i][3].x * inv, v[i][3].y * inv, v[i][3].z * inv, v[i][3].w * inv);
            const int c = i * 8 + (lane >> 3);
            *(uint4*)(dst + ((size_t)c * 16384 + e) * 128 + (lane & 7) * 16) = o; }
#pragma unroll
        for (int i = 0; i < 4; ++i)
#pragma unroll
            for (int q = 0; q < 4; ++q) v[i][q] = nv[i][q];
    }
#undef CV_LOAD
}

__device__ __forceinline__ unsigned nib(float x) { return (unsigned)__float2int_rn(fminf(fmaxf(x, -7.f), 7.f)) & 15u; }
__device__ __forceinline__ unsigned pk8_i4(float4 a, float4 b, float inv) {
    return nib(a.x * inv) | (nib(a.y * inv) << 4) | (nib(a.z * inv) << 8) | (nib(a.w * inv) << 12) | (nib(b.x * inv) << 16) | (nib(b.y * inv) << 20) | (nib(b.z * inv) << 24) | (nib(b.w * inv) << 28); }
__device__ __forceinline__ void p0_peer_cvt_i4(const float* src, unsigned char* dst, float* scale, int blk, int nblk) {
    const int tid = threadIdx.x, w = tid >> 6, lane = tid & 63, step = nblk * NWAVES;
    int e = blk * NWAVES + w; if (e >= 16384) return;
    float4 v[4][4];
#define CV_LOAD(X, ee) do { const float* r_ = src + (size_t)(ee) * DM + lane * 16; \
        _Pragma("unroll") for (int i = 0; i < 4; ++i) _Pragma("unroll") for (int q = 0; q < 4; ++q) X[i][q] = *(const float4*)(r_ + i * 1024 + q * 4); } while (0)
    CV_LOAD(v, e);
#pragma unroll 1
    for (; e < 16384; e += step) {
        float4 nv[4][4];
        const int en = e + step < 16384 ? e + step : e;
        CV_LOAD(nv, en);
        float m = 0.f, ss = 0.f;
#pragma unroll
        for (int i = 0; i < 4; ++i)
#pragma unroll
            for (int q = 0; q < 4; ++q) { m = fmaxf(m, fmaxf(fmaxf(fabsf(v[i][q].x), fabsf(v[i][q].y)), fmaxf(fabsf(v[i][q].z), fabsf(v[i][q].w))));
                ss += v[i][q].x * v[i][q].x + v[i][q].y * v[i][q].y + v[i][q].z * v[i][q].z + v[i][q].w * v[i][q].w; }
        m = wave_max(m); ss = wave_sum(ss);
        const float clipv = fminf(m, 2.6f * sqrtf(ss * (1.0f / DM))), sc = clipv * (1.0f / 7.0f);
        const float inv = sc > 0.f ? 1.0f / sc : 0.f;
        if (lane == 0) scale[e] = sc;
#pragma unroll
        for (int i = 0; i < 4; ++i) { uint2 o; o.x = pk8_i4(v[i][0], v[i][1], inv); o.y = pk8_i4(v[i][2], v[i][3], inv);
            const int c = i * 4 + (lane >> 4);
            *(uint2*)(dst + ((size_t)c * 16384 + e) * 128 + (lane & 15) * 8) = o; }
#pragma unroll
        for (int i = 0; i < 4; ++i)
#pragma unroll
            for (int q = 0; q < 4; ++q) v[i][q] = nv[i][q];
    }
#undef CV_LOAD
}

__device__ __forceinline__ void p10_peer_u8v(const unsigned char* Hq, const float* hqs, const unsigned char* U8, const float* USC, const float* VSC, const unsigned* eidx, const float* gw, LAS unsigned char* lds, int blk) {
    const int tid = threadIdx.x, wv = tid >> 6, lane = tid & 63, tl = lane >> 3, j = lane & 7;
    LAS unsigned* eo = (LAS unsigned*)lds;
    const int base = blk * 64;
    for (int i = tid; i < 64 * 128; i += NTHR) eo[i] = eidx[(size_t)base * 128 + i] * 128u;
    __syncthreads();
    const int tok = base + wv * 8 + tl;
    const LAS unsigned* myeo = eo + (wv * 8 + tl) * 128;
    const __amdgpu_buffer_rsrc_t urs = __builtin_amdgcn_make_buffer_rsrc((void*)U8, 0, 0x7fffffff, 0x00020000);
    int acc[128];
#pragma unroll
    for (int k = 0; k < 128; ++k) acc[k] = 0;
    const unsigned char* hrow = Hq + (size_t)tok * DM + j * 32;
    uint4 ub[2][8];
#define U8V_LOAD(g, B, cc) do { const int so_ = (cc) * (int)PEER8_SLAB; \
        _Pragma("unroll") for (int q = 0; q < 4; ++q) { ub[B][q] = __builtin_bit_cast(uint4, __builtin_amdgcn_raw_buffer_load_b128(urs, (int)ofa[q] + j * 16, so_, 0)); \
            ub[B][4 + q] = __builtin_bit_cast(uint4, __builtin_amdgcn_raw_buffer_load_b128(urs, (int)ofb[q] + j * 16, so_, 0)); } \
        ofa = *(const LAS u4*)(me + ((((g) + 1) & 15) * 8)); ofb = *(const LAS u4*)(me + ((((g) + 1) & 15) * 8) + 4);     \
        asm volatile("" ::: "memory"); __builtin_amdgcn_sched_barrier(0); } while (0)
#define U8V_DOT(g, B) do { _Pragma("unroll") for (int q = 0; q < 8; ++q) { int a = acc[(g) * 8 + q], t = 0; const unsigned uu[4] = {ub[B][q].x, ub[B][q].y, ub[B][q].z, ub[B][q].w}; \
        _Pragma("unroll") for (int d = 0; d < 4; ++d) { t = __builtin_amdgcn_sdot8((int)uu[d], (int)hv[2 * d], t, false); a = __builtin_amdgcn_sdot8((int)uu[d], (int)hv[2 * d + 1], a, false); } \
        acc[(g) * 8 + q] = a + (t << 4); } __builtin_amdgcn_sched_barrier(0); } while (0)
    const LAS unsigned* me = myeo;
    u4 ofa = *(const LAS u4*)me, ofb = *(const LAS u4*)(me + 4);
    uint4 hn0 = *(const uint4*)hrow, hn1 = *(const uint4*)(hrow + 16);
    U8V_LOAD(0, 0, 0);
#pragma unroll 1
    for (int c = 0; c < 16; ++c) {
        asm volatile("" : "+v"(me));
        const uint4 h0 = hn0, h1 = hn1;
        { const int cn = c + 1 < 16 ? c + 1 : c; hn0 = *(const uint4*)(hrow + cn * 256); hn1 = *(const uint4*)(hrow + cn * 256 + 16); }
        const unsigned hv[8] = {h0.x, h0.y, h0.z, h0.w, h1.x, h1.y, h1.z, h1.w};
        U8V_LOAD(1, 1, c); U8V_DOT(0, 0);
        U8V_LOAD(2, 0, c); U8V_DOT(1, 1);
        U8V_LOAD(3, 1, c); U8V_DOT(2, 0);
        U8V_LOAD(4, 0, c); U8V_DOT(3, 1);
        U8V_LOAD(5, 1, c); U8V_DOT(4, 0);
        U8V_LOAD(6, 0, c); U8V_DOT(5, 1);
        U8V_LOAD(7, 1, c); U8V_DOT(6, 0);
        U8V_LOAD(8, 0, c); U8V_DOT(7, 1);
        U8V_LOAD(9, 1, c); U8V_DOT(8, 0);
        U8V_LOAD(10, 0, c); U8V_DOT(9, 1);
        U8V_LOAD(11, 1, c); U8V_DOT(10, 0);
        U8V_LOAD(12, 0, c); U8V_DOT(11, 1);
        U8V_LOAD(13, 1, c); U8V_DOT(12, 0);
        U8V_LOAD(14, 0, c); U8V_DOT(13, 1);
        U8V_LOAD(15, 1, c); U8V_DOT(14, 0);
        { const int cn = c + 1 < 16 ? c + 1 : c; U8V_LOAD(0, 0, cn); }
        U8V_DOT(15, 1);
    }
#undef U8V_LOAD
#undef U8V_DOT
#pragma unroll
    for (int i = 0; i < 64; ++i) { const bool up = (j & 4) != 0; const int snd = up ? acc[i] : acc[i + 64], kp = up ? acc[i + 64] : acc[i]; acc[i] = kp + __shfl_xor(snd, 4); }
#pragma unroll
    for (int i = 0; i < 32; ++i) { const bool up = (j & 2) != 0; const int snd = up ? acc[i] : acc[i + 32], kp = up ? acc[i + 32] : acc[i]; acc[i] = kp + __shfl_xor(snd, 2); }
#pragma unroll
    for (int i = 0; i < 16; ++i) { const bool up = (j & 1) != 0; const int snd = up ? acc[i] : acc[i + 16], kp = up ? acc[i + 16] : acc[i]; acc[i] = kp + __shfl_xor(snd, 1); }
    const int k0 = ((j >> 2) & 1) * 64 + ((j >> 1) & 1) * 32 + (j & 1) * 16; const float hs = hqs[tok];
    const float* gp = gw + (size_t)tok * 128 + k0; const unsigned* ep = eidx + (size_t)tok * 128 + k0;
    LAS float* wp = (LAS float*)(eo + 64 * 128) + (wv * 8 + tl) * 128 + k0;
#pragma unroll
    for (int i = 0; i < 16; i += 4) { f4 g = *(const f4*)(gp + i); const u4 e4 = *(const u4*)(ep + i);
        g[0] *= gelu_exact((float)acc[i] * hs * USC[e4[0]]); g[1] *= gelu_exact((float)acc[i + 1] * hs * USC[e4[1]]); g[2] *= gelu_exact((float)acc[i + 2] * hs * USC[e4[2]]); g[3] *= gelu_exact((float)acc[i + 3] * hs * USC[e4[3]]);
        g[0] *= VSC[e4[0]]; g[1] *= VSC[e4[1]]; g[2] *= VSC[e4[2]]; g[3] *= VSC[e4[3]]; *(LAS f4*)(wp + i) = g; }
    __syncthreads();
}

__device__ __forceinline__ void p11_peer_v8(const unsigned char* V8, const float* gate2, const float* x1, float* out, LAS unsigned char* lds, int blk) {
    const int tid = threadIdx.x, wv = tid >> 6, lane = tid & 63, tl = lane >> 3, j = lane & 7;
    LAS unsigned* eo = (LAS unsigned*)lds; LAS float* wl = (LAS float*)(eo + 64 * 128);
    const int base = blk * 64;
    const int tok = base + wv * 8 + tl, b = tok / NT;
    const LAS unsigned* myeo = eo + (wv * 8 + tl) * 128; const LAS float* mywl = wl + (wv * 8 + tl) * 128;
    const __amdgpu_buffer_rsrc_t vrs = __builtin_amdgcn_make_buffer_rsrc((void*)V8, 0, 0x7fffffff, 0x00020000);
    constexpr int NBUF = 4;
    uint4 vb[NBUF][8];
#define V8_LOAD(B, g, cc) do { const int so_ = (cc) * (int)PEER8_SLAB; \
        _Pragma("unroll") for (int q = 0; q < 4; ++q) { vb[B][q] = __builtin_bit_cast(uint4, __builtin_amdgcn_raw_buffer_load_b128(vrs, (int)ofa[q] + j * 16, so_, 0)); vb[B][4 + q] = __builtin_bit_cast(uint4, __builtin_amdgcn_raw_buffer_load_b128(vrs, (int)ofb[q] + j * 16, so_, 0)); } \
        { const LAS unsigned* mo_ = myeo; asm volatile("" : "+v"(mo_)); ofa = *(const LAS u4*)(mo_ + ((((g) + 1) & 15) * 8)); ofb = *(const LAS u4*)(mo_ + ((((g) + 1) & 15) * 8) + 4); }     \
        asm volatile("" ::: "memory"); __builtin_amdgcn_sched_barrier(0); } while (0)
#define V8_FMA(B, g) do { const f4 wa = wfa, wb = wfb; { const LAS float* mw_ = mywl; asm volatile("" : "+v"(mw_)); wfa = *(const LAS f4*)(mw_ + ((((g) + 1) & 15) * 8)); wfb = *(const LAS f4*)(mw_ + ((((g) + 1) & 15) * 8) + 4); }     \
        _Pragma("unroll") for (int q = 0; q < 8; ++q) { unsigned uu[4] = {vb[B][q].x, vb[B][q].y, vb[B][q].z, vb[B][q].w}; const float w = q < 4 ? wa[q & 3] : wb[q & 3]; \
            asm volatile("" : "+v"(uu[0]), "+v"(uu[1]), "+v"(uu[2]), "+v"(uu[3]));     \
            const f2v w2 = {w, w}; \
            _Pragma("unroll") for (int d = 0; d < 4; ++d) { acc[2 * d] = __builtin_elementwise_fma(w2, __builtin_amdgcn_cvt_pk_f32_fp8((int)uu[d], false), acc[2 * d]); acc[2 * d + 1] = __builtin_elementwise_fma(w2, __builtin_amdgcn_cvt_pk_f32_fp8((int)uu[d], true), acc[2 * d + 1]); } \
            asm volatile("" : "+v"(acc[0]), "+v"(acc[1]), "+v"(acc[2]), "+v"(acc[3]), "+v"(acc[4]), "+v"(acc[5]), "+v"(acc[6]), "+v"(acc[7])); } } while (0)
    u4 ofa = *(const LAS u4*)myeo, ofb = *(const LAS u4*)(myeo + 4);
    f4 wfa = *(const LAS f4*)mywl, wfb = *(const LAS f4*)(mywl + 4);
#pragma unroll
    for (int g = 0; g < NBUF - 1; ++g) V8_LOAD(g, g, 0);
#pragma unroll 1
    for (int c = 0; c < 32; ++c) {
        f2v acc[8];
#pragma unroll
        for (int i = 0; i < 8; ++i) acc[i] = f2v{0.f, 0.f};
        const int col = c * 128 + j * 16; const float* xp = x1 + (size_t)tok * DM + col; const float* gp = gate2 + (size_t)b * NMOD + col;
        f4 xq[4], gq[4];
#pragma unroll
        for (int q = 0; q < 4; ++q) { xq[q] = *(const f4*)(xp + q * 4); gq[q] = *(const f4*)(gp + q * 4); }
#pragma unroll
        for (int g = 0; g < 16; ++g) {
            const int gn = g + NBUF - 1;
            if (gn < 16) V8_LOAD(gn % NBUF, gn, c); else { const int cn = c + 1 < 32 ? c + 1 : c; V8_LOAD(gn % NBUF, gn - 16, cn); }
            V8_FMA(g % NBUF, g);
        }
        float* op = out + (size_t)tok * DM + col;
#pragma unroll
        for (int q = 0; q < 4; ++q) { f4 xv = xq[q]; const f4 gv = gq[q];
            xv[0] += gv[0] * acc[q * 2][0]; xv[1] += gv[1] * acc[q * 2][1]; xv[2] += gv[2] * acc[q * 2 + 1][0]; xv[3] += gv[3] * acc[q * 2 + 1][1]; *(f4*)(op + q * 4) = xv; }
    }
    __syncthreads();
}

}
namespace {
constexpr size_t WS_H8 = WS_END_F;
constexpr size_t WS_HSC = WS_H8 + (size_t)NTOK * DM;
constexpr size_t WS_W8 = WS_HSC + 65536;
constexpr size_t WS_SB = WS_W8 + (size_t)PLD * DM;
constexpr size_t WS_END_G = WS_SB + 32768;
constexpr size_t CTL_AMAXW = 32768;

struct EpiBf16S {
    static constexpr bool PERM = true, AFTER_DRAIN = false;
    bf16_t* O; int ldc; const float* sa; const float* sb;
    __device__ __forceinline__ void operator()(const pg8::f32x4 (&acc)[2][2][4][2], const pg8::Unit& u, int wr, int wc, int fr, int fq) const {
        using pg8::f32x4; using pg8::HALF; using pg8::BM;
        const int row0 = u.pm * BM + wr * 64 + fr, col0 = u.pn * BM + wc * 32 + 8 * fq;
        f32x4 bv[2][2];
#pragma unroll
        for (int bj = 0; bj < 2; ++bj)
#pragma unroll
            for (int n = 0; n < 2; ++n) bv[bj][n] = *(const f32x4*)(sb + col0 + bj * HALF + 4 * n);
#pragma unroll
        for (int ai = 0; ai < 2; ++ai)
#pragma unroll
            for (int m = 0; m < 4; ++m) { const int row = row0 + ai * HALF + m * 16; const float s = sa[row]; bf16_t* rowp = O + (size_t)row * ldc + col0;
#pragma unroll
                for (int bj = 0; bj < 2; ++bj) { const f32x4 v0 = acc[ai][bj][m][0] * bv[bj][0] * s, v1 = acc[ai][bj][m][1] * bv[bj][1] * s;
                    pg8::u32x4 w; w.x = pg8::cvt_pk_bf16(v0[0], v0[1]); w.y = pg8::cvt_pk_bf16(v0[2], v0[3]); w.z = pg8::cvt_pk_bf16(v1[0], v1[1]); w.w = pg8::cvt_pk_bf16(v1[2], v1[3]);
                    *(pg8::u32x4*)(rowp + bj * HALF) = w; } }
    }
};

__device__ __forceinline__ void p1_norm_fp8(const float* x, const float* g, const float* part, const float* b_ada, float* mod_out, unsigned char* H8, float* SA,
                                            const bf16_t* WinT, const unsigned* amax, unsigned char* W8, float* SB, LAS unsigned char* lds, int blk, int nblk) {
    const int tid = threadIdx.x, lane = tid & 63, wv = tid >> 6; const int b = (blk * 64) / NT;
    LAS float* av = (LAS float*)lds; LAS float* sv = av + DM;
    for (int i = tid; i < DM; i += NTHR) { av[i] = g[i] * (1.0f + mod_reduce(part, b_ada, b, 1 * DM + i)); sv[i] = mod_reduce(part, b_ada, b, 0 * DM + i); }
    for (int o = blk * 768 + tid; o < blk * 768 + 768; o += NTHR) mod_out[o] = mod_reduce(part, b_ada, o / NMOD, o % NMOD);
    for (int n = blk * NWAVES + wv; n < PLD; n += nblk * NWAVES) {
        const float am = __uint_as_float(amax[n]); const float inv = am > 0.f ? 448.0f / am : 1.0f;
        if (lane == 0) SB[n] = am > 0.f ? am * (1.0f / 448.0f) : 1.0f;
        const bf16_t* wr = WinT + (size_t)n * DM + lane * 8; unsigned char* wo = W8 + (size_t)n * DM + lane * 8;
        uint4 u[8];
#pragma unroll
        for (int i = 0; i < 8; ++i) u[i] = *(const uint4*)(wr + i * 512);
#pragma unroll
        for (int i = 0; i < 8; ++i) { uint2 o;
            o.x = pk4_fp8(__uint_as_float(u[i].x << 16) * inv, __uint_as_float(u[i].x & 0xffff0000u) * inv, __uint_as_float(u[i].y << 16) * inv, __uint_as_float(u[i].y & 0xffff0000u) * inv);
            o.y = pk4_fp8(__uint_as_float(u[i].z << 16) * inv, __uint_as_float(u[i].z & 0xffff0000u) * inv, __uint_as_float(u[i].w << 16) * inv, __uint_as_float(u[i].w & 0xffff0000u) * inv);
            *(uint2*)(wo + i * 512) = o; }
    }
    __syncthreads();
#pragma unroll 1
    for (int tt = wv; tt < 64; tt += NWAVES) {
        const int tok = blk * 64 + tt; const float* xr = x + (size_t)tok * DM;
        float4 v[16]; float ss = 0.f;
#pragma unroll
        for (int i = 0; i < 16; ++i) { v[i] = *(const float4*)(xr + i * 256 + lane * 4); ss += v[i].x * v[i].x + v[i].y * v[i].y + v[i].z * v[i].z + v[i].w * v[i].w; }
        ss = wave_sum(ss); const float rstd = rsqrtf(ss * (1.0f / DM) + 1e-6f);
        float m = 0.f;
#pragma unroll
        for (int i = 0; i < 16; ++i) { const int col = i * 256 + lane * 4; const f4 a = *(const LAS f4*)(av + col), s = *(const LAS f4*)(sv + col);
            v[i].x = v[i].x * rstd * a[0] + s[0]; v[i].y = v[i].y * rstd * a[1] + s[1]; v[i].z = v[i].z * rstd * a[2] + s[2]; v[i].w = v[i].w * rstd * a[3] + s[3];
            m = fmaxf(m, fmaxf(fmaxf(fabsf(v[i].x), fabsf(v[i].y)), fmaxf(fabsf(v[i].z), fabsf(v[i].w)))); }
        m = wave_max(m); const float inv = m > 0.f ? 448.0f / m : 1.0f;
        if (lane == 0) SA[tok] = m > 0.f ? m * (1.0f / 448.0f) : 1.0f;
#pragma unroll
        for (int i = 0; i < 16; ++i) *(unsigned*)(H8 + (size_t)tok * DM + i * 256 + lane * 4) = pk4_fp8(v[i].x * inv, v[i].y * inv, v[i].z * inv, v[i].w * inv);
    }
    __syncthreads();
}


}
namespace {
constexpr size_t WS_MIX8 = WS_END_G;
constexpr size_t WS_SAM = WS_MIX8 + (size_t)NTOK * DM;
constexpr size_t WS_WO8 = WS_SAM + 65536;
constexpr size_t WS_SBO = WS_WO8 + (size_t)DM * DM;
constexpr size_t WS_END_H = WS_SBO + 16384;
constexpr size_t WS_HQ = WS_END_H;
constexpr size_t WS_HQS = WS_HQ + (size_t)NTOK * DM;
constexpr size_t WS_END_I = WS_HQS + 65536;
constexpr size_t CTL_AMAXO = 16384;

struct EpiResidS {
    static constexpr bool PERM = false, AFTER_DRAIN = false;
    const float* X; float* C; int ldc; const float* gate; const float* sa; const float* sb;
    __device__ __forceinline__ void operator()(const pg8::f32x4 (&acc)[2][2][4][2], const pg8::Unit& u, int wr, int wc, int fr, int fq) const {
        using pg8::f32x4; using pg8::HALF; using pg8::BM;
        const int row0 = u.pm * BM + wr * 64 + fr, col0 = u.pn * BM + wc * 32 + 4 * fq;
        const float* gp = gate + (size_t)(u.pm >> 3) * NMOD;
        f32x4 gv[2][2];
#pragma unroll
        for (int bj = 0; bj < 2; ++bj)
#pragma unroll
            for (int n = 0; n < 2; ++n) gv[bj][n] = *(const f32x4*)(gp + col0 + bj * HALF + n * 16) * *(const f32x4*)(sb + col0 + bj * HALF + n * 16);
#pragma unroll
        for (int ai = 0; ai < 2; ++ai)
#pragma unroll
            for (int m = 0; m < 4; ++m) { const int row = row0 + ai * HALF + m * 16; const float s = sa[row]; const size_t off = (size_t)row * ldc + col0;
#pragma unroll
                for (int bj = 0; bj < 2; ++bj)
#pragma unroll
                    for (int n = 0; n < 2; ++n) { const f32x4 xv = *(const f32x4*)(X + off + bj * HALF + n * 16); *(f32x4*)(C + off + bj * HALF + n * 16) = xv + gv[bj][n] * acc[ai][bj][m][n] * s; }
                asm volatile("" ::: "memory"); }
    }
};

template <bool ROWMAX>
__device__ __forceinline__ void rows_to_fp8(const bf16_t* src, int nrows, const unsigned* amax, unsigned char* dst, float* scale, int blk, int nblk) {
    const int tid = threadIdx.x, lane = tid & 63, wv = tid >> 6, step = nblk * NWAVES;
    int r = blk * NWAVES + wv; if (r >= nrows) return;
    uint4 u[8];
    { const bf16_t* sp = src + (size_t)r * DM + lane * 8;
#pragma unroll
      for (int i = 0; i < 8; ++i) u[i] = *(const uint4*)(sp + i * 512); }
#pragma unroll 1
    for (; r < nrows; r += step) {
        const int rn = r + step < nrows ? r + step : r;
        uint4 un[8];
        { const bf16_t* sp = src + (size_t)rn * DM + lane * 8;
#pragma unroll
          for (int i = 0; i < 8; ++i) un[i] = *(const uint4*)(sp + i * 512); }
        unsigned char* dp = dst + (size_t)r * DM + lane * 8;
        float am;
        if (ROWMAX) { float m = 0.f;
#pragma unroll
            for (int i = 0; i < 8; ++i) { const unsigned w4[4] = {u[i].x, u[i].y, u[i].z, u[i].w};
#pragma unroll
                for (int e = 0; e < 4; ++e) m = fmaxf(m, fmaxf(fabsf(__uint_as_float(w4[e] << 16)), fabsf(__uint_as_float(w4[e] & 0xffff0000u)))); }
            am = wave_max(m); } else am = __uint_as_float(amax[r]);
        const float inv = am > 0.f ? 448.0f / am : 1.0f;
        if (lane == 0) scale[r] = am > 0.f ? am * (1.0f / 448.0f) : 1.0f;
#pragma unroll
        for (int i = 0; i < 8; ++i) { uint2 o;
            o.x = pk4_fp8(__uint_as_float(u[i].x << 16) * inv, __uint_as_float(u[i].x & 0xffff0000u) * inv, __uint_as_float(u[i].y << 16) * inv, __uint_as_float(u[i].y & 0xffff0000u) * inv);
            o.y = pk4_fp8(__uint_as_float(u[i].z << 16) * inv, __uint_as_float(u[i].z & 0xffff0000u) * inv, __uint_as_float(u[i].w << 16) * inv, __uint_as_float(u[i].w & 0xffff0000u) * inv);
            *(uint2*)(dp + i * 512) = o; }
#pragma unroll
        for (int i = 0; i < 8; ++i) u[i] = un[i];
    }
}
}
__global__ void __launch_bounds__(NTHR, 2) fwd(Args args) {
    extern __shared__ __attribute__((aligned(16))) unsigned char lds_raw[];
    LAS unsigned char* lds = (LAS unsigned char*)lds_raw;
    const int tid = threadIdx.x, blk = blockIdx.x, nblk = gridDim.x;
    unsigned char* ws = args.ws;
    const float* x = args.in[0]; const float* c = args.in[1]; const float* w_ada = args.in[2]; const float* b_ada = args.in[3];
    const float* norm1_g = args.in[4]; const float* norm2_g = args.in[5]; const float* w_in = args.in[6]; const float* w_out = args.in[7];
    const float* w_pool = args.in[8]; const float* pool_scale = args.in[9]; const float* q_norm_g = args.in[10]; const float* k_norm_g = args.in[11];
    const float* cmp_pe = args.in[12]; const float* cmp_w1 = args.in[13]; const float* cmp_w2 = args.in[14];
    const float* w_pq = args.in[15]; const float* peer_keys = args.in[16]; const float* peer_u = args.in[17]; const float* peer_v = args.in[18];
    float* mod = (float*)(ws + WS_MOD);
    bf16_t* WinT = (bf16_t*)(ws + WS_WINT); bf16_t* WoutT = (bf16_t*)(ws + WS_WOUTT); bf16_t* WpqT = (bf16_t*)(ws + WS_WPQT);
    bf16_t* H = (bf16_t*)(ws + WS_H); bf16_t* PROJ = (bf16_t*)(ws + WS_PROJ); bf16_t* MIX = (bf16_t*)(ws + WS_MIX); bf16_t* QP = (bf16_t*)(ws + WS_QP);
    bf16_t* UB = (bf16_t*)(ws + WS_UB); bf16_t* VB = (bf16_t*)(ws + WS_VB); bf16_t* KEYSB = (bf16_t*)(ws + WS_KEYSB); unsigned* EIDX = (unsigned*)(ws + WS_EIDX); float* GW = (float*)(ws + WS_GW);
    float* ROPE = (float*)(ws + WS_ROPE); bf16_t* WPT = (bf16_t*)(ws + WS_WPT); bf16_t* W1T = (bf16_t*)(ws + WS_W1T); bf16_t* W2T = (bf16_t*)(ws + WS_W2T); float* PEB = (float*)(ws + WS_PEB);
    bf16_t* KSEL = (bf16_t*)(ws + WS_KSEL); bf16_t* KWIN = (bf16_t*)(ws + WS_KWIN); bf16_t* CMPK = (bf16_t*)(ws + WS_CMPK); bf16_t* CMPV = (bf16_t*)(ws + WS_CMPV);
    bf16_t* OC = (bf16_t*)(ws + WS_OC); unsigned* SELM = (unsigned*)(ws + WS_SELM);
    volatile LAS unsigned* xbw = (volatile LAS unsigned*)(lds + LDS_XBW);
    if (tid < 4) xbw[tid] = 0u;
    __syncthreads();
    const int lo = args.ph_lo, hi = args.ph_hi;
    XcdBarrier bar = xcd_barrier_post((unsigned*)(ws + WS_CTL) + args.li * XCD_BAR_WORDS, xbw);
#define IN(k) (lo <= (k) && (k) < hi)
#ifndef MK_REP_MASK
#define MK_REP_MASK 0
#endif
#define REP(k) ((MK_REP_MASK >> (k)) & 1)
#define SEAM(k) do { if (IN(k) && IN((k) + 1)) xcd_barrier(bar); } while (0)

    if (IN(0)) {
#pragma unroll 1
        for (int rp = 0; rp <= REP(0); ++rp) {
        p0_mod(c, w_ada, (float*)(ws + WS_PART), lds, blk);
        p0_transpose(w_in, DM, INW, PLD, WinT, lds, blk, nblk, (unsigned*)(ws + WS_CTL + CTL_AMAXW));
#pragma unroll 1
        for (int gi = 0; gi < 4; ++gi) p0_frag(w_pool + (size_t)gi * 65536, 1, 256, 8, 16, WPT + (size_t)gi * 65536, blk, nblk);
#pragma unroll 1
        for (int kv = 0; kv < 2; ++kv) { p0_frag(cmp_w1 + (size_t)kv * 4096 * 256, 1, 256, 8, 256, W1T + (size_t)kv * 256 * 4096, blk, nblk);
            p0_transpose(cmp_w2 + (size_t)kv * 256 * 128, 256, 128, 128, W2T + (size_t)kv * 128 * 256, lds, blk, nblk); }
#pragma unroll 1
        for (int li = 0; li < 16; ++li) p0_frag(peer_keys + (size_t)li * 16384, 128, 1, 4, 8, KEYSB + (size_t)li * 16384, blk, nblk);
        p0_rope(ROPE, blk, nblk);
        p0_peb(cmp_pe, cmp_w1, PEB, lds, blk);
            if (rp < REP(0)) xcd_barrier(bar); }
    }
    SEAM(0);
    if (IN(1)) {
#pragma unroll 1
        for (int rp = 0; rp <= REP(1); ++rp) { p1_norm_fp8(x, norm1_g, (const float*)(ws + WS_PART), b_ada, mod, ws + WS_H8, (float*)(ws + WS_HSC), WinT, (const unsigned*)(ws + WS_CTL + CTL_AMAXW), ws + WS_W8, (float*)(ws + WS_SB), lds, blk, nblk);
            if (rp < REP(1)) xcd_barrier(bar); }
    }
    SEAM(1);
    if (IN(2)) {
#pragma unroll 1
        for (int rp = 0; rp <= REP(2); ++rp) {
        pg8::Gemm g{(const bf16_t*)(ws + WS_H8), (const bf16_t*)(ws + WS_W8), NTOK, PLD, DM / 2}; pg8::StaticOrder S; S.init(NTOK, PLD, nblk, blk);
        EpiBf16S E{PROJ, PLD, (const float*)(ws + WS_HSC), (const float*)(ws + WS_SB)};
        pg8::gemm_phase<EpiBf16S, pg8::StaticOrder, false, true>(lds, g, S, E, nullptr);
        if (blk >= 64 && nblk == 256) { const int tb = blk - 64, tn = nblk - 64;
            p0_peer_cvt_i4(peer_u, (unsigned char*)UB, (float*)(ws + WS_USC), tb, tn);
            p0_peer_cvt8(peer_v, (unsigned char*)VB, (float*)(ws + WS_VSC), tb, tn);
            p0_transpose(w_out, DM, DM, DM, WoutT, lds, tb, tn, (unsigned*)(ws + WS_CTL + CTL_AMAXO));
            p0_transpose(w_pq, DM, 2048, 2048, WpqT, lds, tb, tn); }
            if (rp < REP(2)) xcd_barrier(bar); }
    }
    SEAM(2);
    if (IN(3)) {
#pragma unroll 1
        for (int rp = 0; rp <= REP(3); ++rp) {
        for (int r2 = 0; r2 <= REP(12); ++r2) p3_knorm(PROJ, k_norm_g, ROPE, KSEL, KWIN, blk);
        for (int r2 = 0; r2 <= REP(13); ++r2) p3_compress(PROJ, W1T, W2T, PEB, k_norm_g, CMPK, CMPV, lds, blk, nblk);
        for (int r2 = 0; r2 <= REP(14); ++r2) p3_pool(PROJ, WPT, pool_scale, MIX, lds, blk, nblk);
            if (rp < REP(3)) xcd_barrier(bar); }
    }
    SEAM(3);
    if (IN(4)) {
#pragma unroll 1
        for (int rp = 0; rp <= REP(4); ++rp) { p4a_cmp(PROJ, CMPK, CMPV, q_norm_g, OC, SELM, lds, blk, nblk);
            if (rp < REP(4)) xcd_barrier(bar); }
    }
    SEAM(4);
    if (IN(5)) {
#pragma unroll 1
        for (int rp = 0; rp <= REP(5); ++rp) { p4b_attn(PROJ, KSEL, KWIN, SELM, OC, ROPE, q_norm_g, MIX, lds, blk, nblk);
            if (rp < REP(5)) xcd_barrier(bar); }
    }
    SEAM(5);
    if (IN(6)) {
#pragma unroll 1
        for (int rp = 0; rp <= REP(6); ++rp) {
        rows_to_fp8<true>(MIX, NTOK, nullptr, ws + WS_MIX8, (float*)(ws + WS_SAM), blk, nblk);
        rows_to_fp8<false>(WoutT, DM, (const unsigned*)(ws + WS_CTL + CTL_AMAXO), ws + WS_WO8, (float*)(ws + WS_SBO), blk, nblk);
        xcd_barrier(bar);
        pg8::Gemm g{(const bf16_t*)(ws + WS_MIX8), (const bf16_t*)(ws + WS_WO8), NTOK, DM, DM / 2}; pg8::StaticOrder S; S.init(NTOK, DM, nblk, blk);
        EpiResidS E{x, args.out, DM, mod + 2 * DM, (const float*)(ws + WS_SAM), (const float*)(ws + WS_SBO)};
        pg8::gemm_phase<EpiResidS, pg8::StaticOrder, false, true>(lds, g, S, E, nullptr);
            if (rp < REP(6)) xcd_barrier(bar); }
    }
    SEAM(6);
    if (IN(7)) {
#pragma unroll 1
        for (int rp = 0; rp <= REP(7); ++rp) { p_norm_mod<false>(args.out, norm2_g, mod, nullptr, nullptr, nullptr, 3 * DM, 4 * DM, H, lds, blk, ws + WS_HQ, (float*)(ws + WS_HQS));
            if (rp < REP(7)) xcd_barrier(bar); }
    }
    SEAM(7);
    if (IN(8)) {
#pragma unroll 1
        for (int rp = 0; rp <= REP(8); ++rp) {
        pg8::Gemm g{H, WpqT, NTOK, 2048, DM}; pg8::StaticOrder S; S.init(NTOK, 2048, nblk, blk);
        pg8::EpiBf16<0> E{QP, 2048, nullptr, 0, 0};
        pg8::gemm_phase<pg8::EpiBf16<0>, pg8::StaticOrder, false>(lds, g, S, E, nullptr);
            if (rp < REP(8)) xcd_barrier(bar); }
    }
    SEAM(8);
    if (IN(9)) {
#pragma unroll 1
        for (int rp = 0; rp <= REP(9); ++rp) { p8_topk(QP, KEYSB, EIDX, GW, lds, blk, nblk);
            asm volatile("s_waitcnt vmcnt(0)" ::: "memory"); __syncthreads();
            p10_peer_u8v(ws + WS_HQ, (const float*)(ws + WS_HQS), (const unsigned char*)UB, (const float*)(ws + WS_USC), (const float*)(ws + WS_VSC), EIDX, GW, lds, blk);
            p11_peer_v8((const unsigned char*)VB, mod + 5 * DM, args.out, args.out, lds, blk);
            if (rp < REP(9)) xcd_barrier(bar); }
    }
#undef IN
#undef SEAM
}

constexpr int NPHASES = 12;
#ifndef MK_PROBE_NSA
#define MK_PROBE_NSA 0
#endif
#if MK_PROBE_NSA
__global__ void k_probe_ratio(const float* mixf, const bf16_t* mix, float* acc) {
    size_t i = (size_t)blockIdx.x * blockDim.x + threadIdx.x; int c = (int)(i & 4095); float d = 0.f, n = 0.f;
    if (c >= 1024) { n = mixf[i]; d = bf2f(mix[i]) - n; }
    float sd = wave_sum(d * d), sn = wave_sum(n * n);
    if ((threadIdx.x & 63) == 0) { atomicAdd(acc, sd); atomicAdd(acc + 1, sn); }
}
__global__ void k_probe_inject(const float* acc, const float* x, float* out) {
    size_t i = (size_t)blockIdx.x * blockDim.x + threadIdx.x; const float eps = sqrtf(acc[0] / acc[1]);
    out[i] += 100.f * eps * x[i];
}
#endif
#ifndef MK_PER_PHASE
#define MK_PER_PHASE 0
#endif

extern "C" void kernel_launch(void* const* d_in, const int* in_sizes, int n_in, void* d_out, int out_size, void* d_ws, size_t ws_size, hipStream_t stream) {
    static int ready = 0;
    if (!ready) {
        if (hipFuncSetAttribute((const void*)fwd, hipFuncAttributeMaxDynamicSharedMemorySize, LDS_BYTES) != hipSuccess) { fprintf(stderr, "kernel_launch: hipFuncSetAttribute failed\n"); return; }
        if (ws_size < WS_END_I) { fprintf(stderr, "kernel_launch: workspace too small (%zu < %zu)\n", ws_size, (size_t)WS_END_I); return; }
        ready = 1;
    }
    (void)in_sizes; (void)n_in; (void)out_size;
    Args a{};
    for (int i = 0; i < 19; ++i) a.in[i] = (const float*)d_in[i];
    a.out = (float*)d_out; a.ws = (unsigned char*)d_ws; a.ph_lo = 0; a.ph_hi = NPHASES; a.li = 0; a.pad = 0;
    (void)hipMemsetAsync((char*)d_ws + WS_CTL, 0, 65536, stream);
#if MK_PER_PHASE
    for (int p = 0; p < NPHASES; ++p) { a.ph_lo = p; a.ph_hi = p + 1; hipLaunchKernelGGL(fwd, dim3(256), dim3(NTHR), LDS_BYTES, stream, a); }
#else
    hipLaunchKernelGGL(fwd, dim3(256), dim3(NTHR), LDS_BYTES, stream, a);
#endif

#if MK_PROBE_NSA
    {
        char* wsb = (char*)d_ws; size_t off = WS_END_I;
        auto take = [&](size_t bytes) { char* p = wsb + off; off += (bytes + 255) & ~(size_t)255; return p; };
        float* mixf = (float*)take((size_t)NTOK * DM * 4); float* dpool = (float*)take((size_t)NTOK * 1024 * 4);
        float* ksel = (float*)take((size_t)NTOK * 512 * 4); float* kwin = (float*)take((size_t)NTOK * 512 * 4);
        float* cmpb = (float*)take((size_t)2 * NB * 128 * 4 * 128 * 4); unsigned* selmask = (unsigned*)take((size_t)NTOK * 4 * 4);
        const bf16_t* PROJ = (const bf16_t*)(wsb + WS_PROJ); const bf16_t* MIX = (const bf16_t*)(wsb + WS_MIX);
        const float* k_norm_g = (const float*)d_in[11]; const float* q_norm_g = (const float*)d_in[10]; const float* w_pool = (const float*)d_in[8]; const float* pool_scale = (const float*)d_in[9];
        k_pool_d<<<NTOK * 1024 / 256, 256, 0, stream>>>(PROJ, dpool);
        for (int gi = 0; gi < 4; ++gi) k_gemm<<<dim3(4, NTOK / 64), 256, 0, stream>>>(dpool + gi * 256, 1024, w_pool + (size_t)gi * 65536, 256, mixf + gi * 256, DM, NTOK, 256, 256);
        k_pool_scale<<<NTOK * 1024 / 256, 256, 0, stream>>>(mixf, pool_scale);
        k_knorm_rope<<<NTOK, 256, 0, stream>>>(PROJ, k_norm_g, ksel, kwin);
        k_cmp<<<2 * NB * NCMP * 4, 256, 0, stream>>>(PROJ, (const float*)d_in[12], (const float*)d_in[13], (const float*)d_in[14], k_norm_g, cmpb);
        k_attn_cmp<<<NTOK * 4, 128, 0, stream>>>(PROJ, q_norm_g, cmpb, mixf, selmask);
        k_attn_sw<<<NTOK * 4, 256, 0, stream>>>(PROJ, q_norm_g, ksel, kwin, MK_PROBE_NSA == 2 ? selmask : (const unsigned*)(wsb + WS_SELM), mixf);
        float* pacc = (float*)take(256); (void)hipMemsetAsync(pacc, 0, 256, stream);
        k_probe_ratio<<<(unsigned)((size_t)NTOK * DM / 256), 256, 0, stream>>>(mixf, MIX, pacc);
        k_probe_inject<<<(unsigned)((size_t)NTOK * DM / 256), 256, 0, stream>>>(pacc, (const float*)d_in[0], (float*)d_out);
    }
#endif
}
```
